# Optimizing an MI355X kernel written in HIP

```python
import jax, jax.numpy as jnp
from jax import lax
import numpy as np

D_MODEL = 2048
BATCH = 2
SEQ = 4096
DEPTH = 2

N_A_LAYERS = DEPTH // 2
N_B_LAYERS = DEPTH - N_A_LAYERS
EPS = 1e-6
GLA_HEADS = 4
GLA_DK = D_MODEL // 2 // GLA_HEADS
GLA_DV = D_MODEL // GLA_HEADS
GLA_GATE_RANK = 16
GLA_GATE_TAU = 16.0
GLA_CHUNK = 64
GLA_QK_W = GLA_HEADS * GLA_DK
GLA_V_W = GLA_HEADS * GLA_DV
GLA_IN_W = 2 * GLA_QK_W + 2 * GLA_V_W + GLA_GATE_RANK
SB_HEADS = 16
SB_HEAD_DIM = D_MODEL // SB_HEADS
SB_W = SB_HEADS * SB_HEAD_DIM
SB_BLOCK = 128
D_FF = -(-8 * D_MODEL // (3 * 256)) * 256

kernel_name = "yoco_gla_stick_breaking_hybrid"


def rmsnorm(x, w):
    xf = x.astype(jnp.float32)
    xf = xf * lax.rsqrt(jnp.mean(xf * xf, axis=-1, keepdims=True) + EPS)
    return xf.astype(x.dtype) * w


def split_heads(t, n_heads):
    b, s, _ = t.shape
    return t.reshape(b, s, n_heads, -1).transpose(0, 2, 1, 3)


def swiglu(h, w_gate_up, w_down):
    gate, up = jnp.split(h @ w_gate_up, 2, axis=-1)
    return (jax.nn.silu(gate) * up) @ w_down


def gla_chunked(q, k, v, g):
    out_dtype = v.dtype
    q, k, v, g = (t.astype(jnp.float32) for t in (q, k, v, g))
    B, H, S, DK = q.shape
    DV = v.shape[-1]
    C = GLA_CHUNK
    NC = S // C

    def to_chunks(t):
        return t.reshape(B, H, NC, C, t.shape[-1]).transpose(2, 0, 1, 3, 4)

    causal = jnp.tril(jnp.ones((C, C), dtype=bool))[:, :, None]

    def step(state, inp):
        qi, ki, vi, gi = inp
        b = jnp.cumsum(gi, axis=-2)
        o_inter = jnp.einsum('bhck,bhkv->bhcv', qi * jnp.exp(b), state)
        rel = b[..., :, None, :] - b[..., None, :, :]
        decay = jnp.where(causal, jnp.exp(jnp.minimum(rel, 0.0)), 0.0)
        scores = jnp.einsum('bhik,bhjk,bhijk->bhij', qi, ki, decay)
        o_intra = jnp.einsum('bhij,bhjv->bhiv', scores, vi)
        b_last = b[..., -1:, :]
        k_dec = ki * jnp.exp(b_last - b)
        new_state = state * jnp.exp(b_last)[..., 0, :, None] + jnp.einsum('bhck,bhcv->bhkv', k_dec, vi)
        return new_state, o_inter + o_intra

    state0 = jnp.zeros((B, H, DK, DV), jnp.float32)
    _, o = lax.scan(step, state0, (to_chunks(q), to_chunks(k), to_chunks(v), to_chunks(g)))
    return o.transpose(1, 2, 0, 3, 4).reshape(B, H, S, DV).astype(out_dtype)


def gla_mixer(h, w_in, w_gate_up, b_gate, gnorm_w, w_out):
    B, S, _ = h.shape
    proj = h @ w_in
    q, k, v, r, gl = jnp.split(
        proj, [GLA_QK_W, 2 * GLA_QK_W, 2 * GLA_QK_W + GLA_V_W, 2 * GLA_QK_W + 2 * GLA_V_W], axis=-1)
    log_alpha = jax.nn.log_sigmoid((gl @ w_gate_up + b_gate).astype(jnp.float32)) / GLA_GATE_TAU
    o = gla_chunked(split_heads(q, GLA_HEADS) * (GLA_DK ** -0.5), split_heads(k, GLA_HEADS),
                    split_heads(v, GLA_HEADS), split_heads(log_alpha, GLA_HEADS))
    o = rmsnorm(o.transpose(0, 2, 1, 3), gnorm_w)
    o = o * jax.nn.silu(r).reshape(B, S, GLA_HEADS, GLA_DV)
    return o.reshape(B, S, GLA_V_W) @ w_out


def stick_breaking_attention(q, k, v):
    B, H, S, hd = q.shape
    NB = S // SB_BLOCK
    qb = q.reshape(B, H, NB, SB_BLOCK, hd).transpose(2, 0, 1, 3, 4)
    kpos = jnp.arange(S)

    def block(args):
        qi, i = args
        z = jnp.einsum('bhqd,bhkd->bhqk', qi, k).astype(jnp.float32) * (hd ** -0.5)
        qpos = i * SB_BLOCK + jnp.arange(SB_BLOCK)
        mask = kpos[None, :] < qpos[:, None]
        log_fail = jnp.where(mask, jax.nn.log_sigmoid(-z), 0.0)
        after = lax.cumsum(log_fail, axis=log_fail.ndim - 1, reverse=True) - log_fail
        a = jnp.where(mask, jnp.exp(jax.nn.log_sigmoid(z) + after), 0.0)
        return jnp.einsum('bhqk,bhkd->bhqd', a.astype(v.dtype), v)

    o = lax.map(block, (qb, jnp.arange(NB)))
    return o.transpose(1, 2, 0, 3, 4).reshape(B, H, S, hd)


def setup_inputs(seed: int = 0) -> dict:
    key = jax.random.key(seed)
    ks = jax.random.split(key, 20)
    f32 = jnp.float32

    def nrm(k, shape, fan_in):
        return jax.random.normal(k, shape, f32) * (fan_in ** -0.5)

    def gain(k, shape):
        return 1.0 + 0.01 * jax.random.normal(k, shape, f32)

    return {
        "x": jax.random.normal(ks[0], (BATCH, SEQ, D_MODEL), f32),
        "attn_norm_w": gain(ks[1], (DEPTH, D_MODEL)),
        "ffn_norm_w": gain(ks[2], (DEPTH, D_MODEL)),
        "gla_w_in": nrm(ks[3], (N_A_LAYERS, D_MODEL, GLA_IN_W), D_MODEL),
        "gla_w_gate_up": nrm(ks[4], (N_A_LAYERS, GLA_GATE_RANK, GLA_QK_W), GLA_GATE_RANK),
        "gla_b_gate": 0.1 * jax.random.normal(ks[5], (N_A_LAYERS, GLA_QK_W), f32),
        "gla_gnorm_w": gain(ks[6], (N_A_LAYERS, GLA_DV)),
        "gla_w_out": nrm(ks[7], (N_A_LAYERS, GLA_V_W, D_MODEL), GLA_V_W),
        "kv_norm_w": gain(ks[8], (D_MODEL,)),
        "sb_w_kv": nrm(ks[9], (D_MODEL, 2 * SB_W), D_MODEL),
        "sb_w_q": nrm(ks[10], (N_B_LAYERS, D_MODEL, SB_W), D_MODEL),
        "sb_w_out": nrm(ks[11], (N_B_LAYERS, SB_W, D_MODEL), SB_W),
        "ffn_w_gate_up": nrm(ks[12], (DEPTH, D_MODEL, 2 * D_FF), D_MODEL),
        "ffn_w_down": nrm(ks[13], (DEPTH, D_FF, D_MODEL), D_FF),
        "final_norm_w": gain(ks[14], (D_MODEL,)),
    }


def reference(x, attn_norm_w, ffn_norm_w, gla_w_in, gla_w_gate_up, gla_b_gate, gla_gnorm_w, gla_w_out,
              kv_norm_w, sb_w_kv, sb_w_q, sb_w_out, ffn_w_gate_up, ffn_w_down, final_norm_w):
    h = x
    k_shared = None
    v_shared = None
    for layer in range(DEPTH):
        a = rmsnorm(h, attn_norm_w[layer])
        if layer < N_A_LAYERS:
            i = layer
            h = h + gla_mixer(a, gla_w_in[i], gla_w_gate_up[i], gla_b_gate[i], gla_gnorm_w[i], gla_w_out[i])
        else:
            j = layer - N_A_LAYERS
            q = split_heads(a @ sb_w_q[j], SB_HEADS)
            o = stick_breaking_attention(q, k_shared, v_shared)
            o = o.transpose(0, 2, 1, 3).reshape(h.shape[0], h.shape[1], SB_W)
            h = h + o @ sb_w_out[j]
        h = h + swiglu(rmsnorm(h, ffn_norm_w[layer]), ffn_w_gate_up[layer], ffn_w_down[layer])
        if layer == N_A_LAYERS - 1:
            kv = rmsnorm(h, kv_norm_w) @ sb_w_kv
            k_c, v_c = jnp.split(kv, 2, axis=-1)
            k_shared = split_heads(k_c, SB_HEADS)
            v_shared = split_heads(v_c, SB_HEADS)
    return rmsnorm(h, final_norm_w)
```

```cpp
#include <hip/hip_runtime.h>
#include <hip/hip_cooperative_groups.h>
#include <cstdio>
#include <cstdint>
namespace cg = cooperative_groups;
namespace pg8 {
#define PG8_LAS __attribute__((address_space(3)))
typedef unsigned short bf16_t;
typedef short bf16x8 __attribute__((ext_vector_type(8)));
typedef float f32x4 __attribute__((ext_vector_type(4)));
typedef unsigned u32x4 __attribute__((ext_vector_type(4)));
constexpr int BM = 256, BK = 64, HALF = 128, HTB = HALF * BK * 2  , STAGE_BYTES = 8 * HTB, NXCD = 8, WGM = 4;

__host__ __device__ __forceinline__ int lds_byte(int r, int c) { const int st = (r >> 4) * 2 + (c >> 5), rr = r & 15, cc = c & 31, ob = rr * 64 + cc * 2; return st * 1024 + (ob ^ (((ob >> 9) & 1) << 5)); }
__host__ __device__ __forceinline__ void stage_rc(int b, int& R, int& C) { const int st = b / 1024, sb = b % 1024, swz = sb ^ (((sb >> 9) & 1) << 5); R = (st >> 1) * 16 + swz / 64; C = (st & 1) * 32 + (swz % 64) / 2; }
__host__ __device__ __forceinline__ int perm32(int rho) { const int n = rho >> 4, i = rho & 15; return 8 * (i >> 2) + 4 * n + (i & 3); }

struct Unit { int pm, pn; };
struct Gemm { const bf16_t* A; const bf16_t* Bt; int M, N, K; };

struct StaticOrder {
    int nM, nN, nwg, G, c, wgm;
    __host__ __device__ void init(int M, int N, int G_, int c_, int wgm_ = WGM) { nM = M / BM; nN = N / BM; nwg = nM * nN; G = G_; c = c_; wgm = wgm_; }
    __host__ __device__ bool next(int i, Unit& u) const {
        const long L = (long)i * G + c; if (L >= nwg) return false;
        int wgid = (int)L; { const int q = nwg / NXCD, r = nwg % NXCD, xcd = wgid % NXCD, off = wgid / NXCD; wgid = (xcd < r ? xcd * (q + 1) : r * (q + 1) + (xcd - r) * q) + off; }
        const int nig = wgm * nN, gid = wgid / nig, fm = gid * wgm, gsz = (nM - fm) < wgm ? (nM - fm) : wgm;
        u.pm = fm + ((wgid % nig) % gsz); u.pn = (wgid % nig) / gsz; return true;
    }
    __device__ __forceinline__ void a_ready(const Unit&) const {}
    __device__ __forceinline__ void done(const Unit&) const {}
};

template <class Epi, class Sched, bool ALIGN_EPI = false, bool SP2 = false>
__device__ __forceinline__ void gemm_phase(PG8_LAS unsigned char* lds, const Gemm g, const Sched& S, const Epi& E) {
    int tid = threadIdx.x; asm volatile("" : "+v"(tid)); const int wid = __builtin_amdgcn_readfirstlane(tid >> 6), lane = tid & 63, wr = wid >> 2, wc = wid & 3, fr = lane & 15, fq = lane >> 4;
    const int K = g.K, nt = K / BK;
    unsigned voffA[2], voffB[2];
#pragma unroll
    for (int i = 0; i < 2; ++i) { int R, C; stage_rc(tid * 16 + i * 8192, R, C); const int Rb = Epi::PERM ? ((R & ~31) + perm32(R & 31)) : R;
        voffA[i] = (unsigned)(R * K + C) * 2u; voffB[i] = (unsigned)(Rb * K + C) * 2u; }
    const size_t kstep = (size_t)(BK * 2);
    const size_t hstep = (size_t)HALF * K * 2;
    const size_t tstep = 2 * hstep;
    const unsigned ldsw = (unsigned)wid * 1024u;
    const int aoff = lds_byte(wr * 64 + fr, fq * 8), boff = lds_byte(wc * 32 + fr, fq * 8);
#define PG8_SA(b, h) (((b) * 2 + (h)) * HTB)
#define PG8_SB(b, h) ((4 + (b) * 2 + (h)) * HTB)
#define PG8_STAGE(bufoff, gbase, voff) do { _Pragma("unroll") for (int _i = 0; _i < 2; ++_i) \
        __builtin_amdgcn_global_load_lds((const unsigned*)((const char*)(gbase) + (voff)[_i]), (PG8_LAS unsigned*)(lds + (bufoff) + ldsw + _i * 8192), 16, 0, 0); } while (0)
#define PG8_LDA(dst, b, h) do { _Pragma("unroll") for (int m = 0; m < 4; ++m) _Pragma("unroll") for (int k = 0; k < 2; ++k) dst[m][k] = *(const PG8_LAS bf16x8*)(lds + PG8_SA(b, h) + aoff + m * 2048 + k * 1024); } while (0)
#define PG8_LDB(dst, b, h) do { _Pragma("unroll") for (int n = 0; n < 2; ++n) _Pragma("unroll") for (int k = 0; k < 2; ++k) dst[n][k] = *(const PG8_LAS bf16x8*)(lds + PG8_SB(b, h) + boff + n * 2048 + k * 1024); } while (0)
#define PG8_MMA(ai, bj, At, Bt) do { __builtin_amdgcn_s_setprio(1); _Pragma("unroll") for (int m = 0; m < 4; ++m) _Pragma("unroll") for (int n = 0; n < 2; ++n) _Pragma("unroll") for (int k = 0; k < 2; ++k) \
        acc[ai][bj][m][n] = __builtin_amdgcn_mfma_f32_16x16x32_bf16(Bt[n][k], At[m][k], acc[ai][bj][m][n], 0, 0, 0); __builtin_amdgcn_s_setprio(0); } while (0)
#define PG8_WAIT_V(n) asm volatile("s_waitcnt vmcnt(" #n ")" ::: "memory")
#define PG8_WAIT_L(n) asm volatile("s_waitcnt lgkmcnt(" #n ")" ::: "memory")
#define PG8_BAR __builtin_amdgcn_s_barrier()
#define PG8_SCHED __builtin_amdgcn_sched_barrier(0)
    Unit cur, nxt; int ui = 0;
    if (!S.next(0, cur)) return;
    f32x4 acc[2][2][4][2];
#pragma unroll
    for (int a = 0; a < 2; ++a)
#pragma unroll
        for (int b = 0; b < 2; ++b)
#pragma unroll
            for (int m = 0; m < 4; ++m)
#pragma unroll
                for (int n = 0; n < 2; ++n) acc[a][b][m][n] = (f32x4){0.f, 0.f, 0.f, 0.f};
    bf16x8 At[4][2], B0[2][2], B1[2][2];
    const char* cA = (const char*)g.A + (size_t)cur.pm * tstep; const char* cB = (const char*)g.Bt + (size_t)cur.pn * tstep;
    S.a_ready(cur);
    if constexpr (SP2) {
        PG8_STAGE(PG8_SB(0, 0), cB, voffB); PG8_STAGE(PG8_SB(0, 1), cB + hstep, voffB); PG8_STAGE(PG8_SA(0, 0), cA, voffA); PG8_STAGE(PG8_SA(0, 1), cA + hstep, voffA);
        if (wr == 1) PG8_BAR;
        PG8_WAIT_V(2); PG8_BAR;
        PG8_STAGE(PG8_SB(1, 0), cB + kstep, voffB); PG8_STAGE(PG8_SA(1, 0), cA + kstep, voffA); PG8_STAGE(PG8_SB(1, 1), cB + hstep + kstep, voffB);
        PG8_WAIT_V(6); PG8_BAR;
    } else {
        PG8_STAGE(PG8_SB(0, 0), cB, voffB); PG8_STAGE(PG8_SA(0, 0), cA, voffA); PG8_STAGE(PG8_SB(0, 1), cB + hstep, voffB); PG8_STAGE(PG8_SA(0, 1), cA + hstep, voffA);
        if (wr == 1) PG8_BAR;
        PG8_WAIT_V(4); PG8_BAR;
        PG8_STAGE(PG8_SB(1, 0), cB + kstep, voffB); PG8_STAGE(PG8_SA(1, 0), cA + kstep, voffA); PG8_STAGE(PG8_SB(1, 1), cB + hstep + kstep, voffB);
        PG8_WAIT_V(6); PG8_BAR;
    }
    for (;;) {
        const bool has_next = S.next(ui + 1, nxt);
        const char* nA = has_next ? (const char*)g.A + (size_t)nxt.pm * tstep : cA; const char* nB = has_next ? (const char*)g.Bt + (size_t)nxt.pn * tstep : cB;
        for (int t = 0; t < nt; t += 2) {
            const bool last = (t == nt - 2);
            const char* a1 = cA + (size_t)(t + 1) * kstep;
            const char* a2 = last ? nA : cA + (size_t)(t + 2) * kstep; const char* b2 = last ? nB : cB + (size_t)(t + 2) * kstep;
            const char* a3 = a2 + kstep; const char* b3 = b2 + kstep;
            if (last && has_next) S.a_ready(nxt);
            if constexpr (SP2) {
            PG8_LDB(B0, 0, 0); PG8_LDB(B1, 0, 1); PG8_SCHED; PG8_LDA(At, 0, 0); PG8_STAGE(PG8_SA(1, 1), a1 + hstep, voffA);
            PG8_WAIT_V(8); PG8_WAIT_L(0); PG8_BAR; PG8_MMA(0, 0, At, B0); PG8_MMA(0, 1, At, B1); PG8_BAR; PG8_SCHED;
            PG8_LDA(At, 0, 1); PG8_STAGE(PG8_SB(0, 0), b2, voffB); PG8_STAGE(PG8_SB(0, 1), b2 + hstep, voffB); PG8_STAGE(PG8_SA(0, 0), a2, voffA);
            PG8_WAIT_V(8); PG8_WAIT_L(0); PG8_BAR; PG8_MMA(1, 0, At, B0); PG8_MMA(1, 1, At, B1); PG8_BAR; PG8_SCHED;
            PG8_LDB(B0, 1, 0); PG8_LDB(B1, 1, 1); PG8_SCHED; PG8_LDA(At, 1, 0); PG8_STAGE(PG8_SA(0, 1), a2 + hstep, voffA);
            PG8_WAIT_V(8); PG8_WAIT_L(0); PG8_BAR; PG8_MMA(0, 0, At, B0); PG8_MMA(0, 1, At, B1); PG8_BAR; PG8_SCHED;
            PG8_LDA(At, 1, 1); PG8_STAGE(PG8_SB(1, 0), b3, voffB); PG8_STAGE(PG8_SB(1, 1), b3 + hstep, voffB); PG8_STAGE(PG8_SA(1, 0), a3, voffA);
            PG8_WAIT_V(8); PG8_WAIT_L(0); PG8_BAR; PG8_MMA(1, 0, At, B0); PG8_MMA(1, 1, At, B1); PG8_BAR; PG8_SCHED;
            } else {
            PG8_LDB(B0, 0, 0); PG8_SCHED; PG8_LDA(At, 0, 0); PG8_STAGE(PG8_SA(1, 1), a1 + hstep, voffA);
            PG8_WAIT_L(8); PG8_BAR; PG8_WAIT_L(0); PG8_MMA(0, 0, At, B0); PG8_BAR; PG8_SCHED;
            PG8_LDB(B1, 0, 1); PG8_STAGE(PG8_SB(0, 0), b2, voffB);
            PG8_BAR; PG8_WAIT_L(0); PG8_MMA(0, 1, At, B1); PG8_BAR;
            PG8_LDA(At, 0, 1); PG8_STAGE(PG8_SA(0, 0), a2, voffA);
            PG8_BAR; PG8_WAIT_L(0); PG8_MMA(1, 0, At, B0); PG8_BAR; PG8_SCHED;
            PG8_STAGE(PG8_SB(0, 1), b2 + hstep, voffB);
            PG8_WAIT_V(6); PG8_BAR; PG8_MMA(1, 1, At, B1); PG8_BAR;
            PG8_LDB(B0, 1, 0); PG8_SCHED; PG8_LDA(At, 1, 0); PG8_STAGE(PG8_SA(0, 1), a2 + hstep, voffA);
            PG8_WAIT_L(8); PG8_BAR; PG8_WAIT_L(0); PG8_MMA(0, 0, At, B0); PG8_BAR; PG8_SCHED;
            PG8_LDB(B1, 1, 1); PG8_STAGE(PG8_SB(1, 0), b3, voffB);
            PG8_BAR; PG8_WAIT_L(0); PG8_MMA(0, 1, At, B1); PG8_BAR;
            PG8_LDA(At, 1, 1); PG8_STAGE(PG8_SA(1, 0), a3, voffA);
            PG8_BAR; PG8_WAIT_L(0); PG8_MMA(1, 0, At, B0); PG8_BAR; PG8_SCHED;
            PG8_STAGE(PG8_SB(1, 1), b3 + hstep, voffB);
            PG8_WAIT_V(6); PG8_BAR; PG8_MMA(1, 1, At, B1); PG8_BAR;
            }
        }
        if constexpr (ALIGN_EPI) { if (wr == 0) PG8_BAR; }
        if constexpr (!Epi::AFTER_DRAIN) { E(acc, cur, wr, wc, fr, fq); S.done(cur); }
        if (!has_next) break;
#pragma unroll
        for (int a = 0; a < 2; ++a)
#pragma unroll
            for (int b = 0; b < 2; ++b)
#pragma unroll
                for (int m = 0; m < 4; ++m)
#pragma unroll
                    for (int n = 0; n < 2; ++n) acc[a][b][m][n] = (f32x4){0.f, 0.f, 0.f, 0.f};
        cur = nxt; cA = nA; cB = nB; ++ui;
        if constexpr (ALIGN_EPI) { if (wr == 1) PG8_BAR; }
    }
    PG8_WAIT_V(0);
    if constexpr (!ALIGN_EPI) { if (wr == 0) PG8_BAR; }
    PG8_BAR;
    if constexpr (Epi::AFTER_DRAIN) { E.fused(acc, cur, wr, wc, fr, fq, lds, wid, lane); S.done(cur); }
#undef PG8_SA
#undef PG8_SB
#undef PG8_STAGE
#undef PG8_LDA
#undef PG8_LDB
#undef PG8_MMA
#undef PG8_WAIT_V
#undef PG8_WAIT_L
#undef PG8_BAR
#undef PG8_SCHED
}
}
#define GAS __attribute__((address_space(1)))
#define LAS __attribute__((address_space(3)))
typedef unsigned short bf16;
typedef unsigned v4u __attribute__((ext_vector_type(4)));
typedef unsigned v2u __attribute__((ext_vector_type(2)));
typedef float f32x4 __attribute__((ext_vector_type(4)));
typedef float f32x16 __attribute__((ext_vector_type(16)));
typedef short bf16x8 __attribute__((ext_vector_type(8)));
typedef short s16x4 __attribute__((ext_vector_type(4)));

constexpr int NWAVES = 8, NTHR = 512;
constexpr int T = 8192, D = 2048, SEQ = 4096, NBATCH = 2;
constexpr int GH = 4, GDK = 256, GDV = 512, GQK = 1024, GIN = 6160, NQ3 = 6144;
constexpr int FF = 5632, FF2 = 11264;
constexpr int SBH = 16, HD = 128;
constexpr float EPS = 1e-6f;
constexpr float C2 = 0.08838834764831845f * 1.4426950408889634f;
constexpr float SB_DONE = -160.0f;

constexpr size_t MiB = 1u << 20;
constexpr size_t WS_CTL = 0, WS_WIN = 1 * MiB, WS_WGL = 25 * MiB, WS_WOUT = 26 * MiB, WS_WGU0 = 34 * MiB, WS_WD0 = 78 * MiB,
                 WS_WQKV = 100 * MiB, WS_WSBO = 124 * MiB, WS_WGU1 = 132 * MiB, WS_WD1 = 176 * MiB,
                 WS_A = 198 * MiB, WS_QKVR = 230 * MiB, WS_QB = 327 * MiB, WS_KB = 343 * MiB, WS_KDT = 359 * MiB, WS_VT = 375 * MiB,
                 WS_EB = 407 * MiB, WS_SS = 65536, WS_OG = 408 * MiB, WS_H = 472 * MiB, WS_ACT = 536 * MiB, WS_A2 = 624 * MiB, WS_END = 656 * MiB;
constexpr int LDS_BYTES = 147456, MISC_OFF = LDS_BYTES - 64;

__device__ __forceinline__ unsigned cvtpk(float lo, float hi) { unsigned r; asm volatile("v_cvt_pk_bf16_f32 %0, %1, %2" : "=v"(r) : "v"(lo), "v"(hi)); return r; }
__device__ __forceinline__ float bf2f(unsigned short u) { return __builtin_bit_cast(float, (unsigned)u << 16); }
__device__ __forceinline__ float bflo(unsigned u) { return __builtin_bit_cast(float, u << 16); }
__device__ __forceinline__ float bfhi(unsigned u) { return __builtin_bit_cast(float, u & 0xffff0000u); }
__device__ __forceinline__ float wave_sum(float v) {
#pragma unroll
    for (int o = 1; o < 64; o <<= 1) v += __shfl_xor(v, o);
    return v;
}
#define LDS_WAIT() asm volatile("s_waitcnt lgkmcnt(0)" ::: "memory")

__device__ __forceinline__ float rstd_of(const float* ss, int row) { return 1.0f / sqrtf(ss[row] * (1.0f / D) + EPS); }
struct EpiStoreBf16 {
    static constexpr bool PERM = true, AFTER_DRAIN = false;
    bf16* O; int ldc; const float* ss;
    __device__ __forceinline__ void operator()(const pg8::f32x4 (&acc)[2][2][4][2], const pg8::Unit& u, int wr, int wc, int fr, int fq) const {
        const int row0 = u.pm * 256 + wr * 64 + fr, col0 = u.pn * 256 + wc * 32 + 8 * fq;
#pragma unroll
        for (int ai = 0; ai < 2; ++ai)
#pragma unroll
            for (int m = 0; m < 4; ++m) { bf16* rowp = O + (size_t)(row0 + ai * 128 + m * 16) * ldc + col0; const float rs = ss ? rstd_of(ss, row0 + ai * 128 + m * 16) : 1.0f;
#pragma unroll
                for (int bj = 0; bj < 2; ++bj) { const pg8::f32x4 v0 = acc[ai][bj][m][0] * rs, v1 = acc[ai][bj][m][1] * rs;
                    v4u w; w.x = cvtpk(v0[0], v0[1]); w.y = cvtpk(v0[2], v0[3]); w.z = cvtpk(v1[0], v1[1]); w.w = cvtpk(v1[2], v1[3]);
                    *(v4u*)(rowp + bj * 128) = w; } }
    }
};
template <bool RBF> struct EpiRes {
    static constexpr bool PERM = true, AFTER_DRAIN = false;
    const void* R; int ldc; bf16* A; float* ss;
    __device__ __forceinline__ void operator()(const pg8::f32x4 (&acc)[2][2][4][2], const pg8::Unit& u, int wr, int wc, int fr, int fq) const {
        const int row0 = u.pm * 256 + wr * 64 + fr, col0 = u.pn * 256 + wc * 32 + 8 * fq;
#pragma unroll
        for (int ai = 0; ai < 2; ++ai)
#pragma unroll
            for (int m = 0; m < 4; ++m) { const size_t off = (size_t)(row0 + ai * 128 + m * 16) * ldc + col0; float sq = 0.f;
#pragma unroll
                for (int bj = 0; bj < 2; ++bj) {
                    f32x4 r0, r1;
                    if (RBF) { const v4u x = *(const v4u*)((const bf16*)R + off + bj * 128); r0 = (f32x4){bflo(x.x), bfhi(x.x), bflo(x.y), bfhi(x.y)}; r1 = (f32x4){bflo(x.z), bfhi(x.z), bflo(x.w), bfhi(x.w)}; }
                    else { r0 = *(const f32x4*)((const float*)R + off + bj * 128); r1 = *(const f32x4*)((const float*)R + off + bj * 128 + 4); }
                    r0 = r0 + acc[ai][bj][m][0]; r1 = r1 + acc[ai][bj][m][1];
                    sq += (r0[0] * r0[0] + r0[1] * r0[1]) + (r0[2] * r0[2] + r0[3] * r0[3]) + (r1[0] * r1[0] + r1[1] * r1[1]) + (r1[2] * r1[2] + r1[3] * r1[3]);
                    v4u w; w.x = cvtpk(r0[0], r0[1]); w.y = cvtpk(r0[2], r0[3]); w.z = cvtpk(r1[0], r1[1]); w.w = cvtpk(r1[2], r1[3]);
                    *(v4u*)(A + off + bj * 128) = w; }
                sq += __shfl_xor(sq, 16); sq += __shfl_xor(sq, 32);
                if (fq == 0) atomicAdd(ss + row0 + ai * 128 + m * 16, sq); }
    }
};
struct EpiFinal {
    static constexpr bool PERM = true, AFTER_DRAIN = true;
    const bf16* R; int ldc; float* ss; unsigned* cnt; const float* w; float* out;
    __device__ __forceinline__ void operator()(const pg8::f32x4 (&)[2][2][4][2], const pg8::Unit&, int, int, int, int) const {}
    __device__ __forceinline__ void fused(const pg8::f32x4 (&acc_)[2][2][4][2], const pg8::Unit& u, int wr, int wc, int fr, int fq, PG8_LAS unsigned char* lds, int wid, int lane) const {
        pg8::f32x4 (&acc)[2][2][4][2] = const_cast<pg8::f32x4 (&)[2][2][4][2]>(acc_);
        const int row0 = u.pm * 256 + wr * 64 + fr, col0 = u.pn * 256 + wc * 32 + 8 * fq;
#pragma unroll
        for (int ai = 0; ai < 2; ++ai)
#pragma unroll
            for (int m = 0; m < 4; ++m) { const size_t off = (size_t)(row0 + ai * 128 + m * 16) * ldc + col0; float sq = 0.f;
#pragma unroll
                for (int bj = 0; bj < 2; ++bj) { const v4u x = *(const v4u*)(R + off + bj * 128);
                    const f32x4 r0 = (f32x4){bflo(x.x), bfhi(x.x), bflo(x.y), bfhi(x.y)} + acc[ai][bj][m][0], r1 = (f32x4){bflo(x.z), bfhi(x.z), bflo(x.w), bfhi(x.w)} + acc[ai][bj][m][1];
                    sq += (r0[0] * r0[0] + r0[1] * r0[1]) + (r0[2] * r0[2] + r0[3] * r0[3]) + (r1[0] * r1[0] + r1[1] * r1[1]) + (r1[2] * r1[2] + r1[3] * r1[3]);
                    acc[ai][bj][m][0] = r0; acc[ai][bj][m][1] = r1; }
                sq += __shfl_xor(sq, 16); sq += __shfl_xor(sq, 32);
                if (fq == 0) atomicAdd(ss + row0 + ai * 128 + m * 16, sq); }
        asm volatile("s_waitcnt vmcnt(0)" ::: "memory");
        unsigned* pc = cnt + 64 * u.pm;
        if (lane == 0) __hip_atomic_fetch_add(pc, 1u, __ATOMIC_RELAXED, __HIP_MEMORY_SCOPE_AGENT);
        if (wid == 0) { unsigned spins = 0;
            while ((unsigned)__builtin_amdgcn_readfirstlane(__hip_atomic_load(pc, __ATOMIC_RELAXED, __HIP_MEMORY_SCOPE_AGENT)) < 64u && ++spins < (1u << 22)) __builtin_amdgcn_s_sleep(2);
            __builtin_amdgcn_fence(__ATOMIC_ACQUIRE, "agent"); }
        asm volatile("s_waitcnt vmcnt(0) lgkmcnt(0)" ::: "memory"); __builtin_amdgcn_s_barrier(); asm volatile("" ::: "memory");
#pragma unroll
        for (int ai = 0; ai < 2; ++ai)
#pragma unroll
            for (int m = 0; m < 4; ++m) { const int row = row0 + ai * 128 + m * 16; const size_t off = (size_t)row * ldc + col0;
                const float rs = 1.0f / sqrtf(__hip_atomic_load(ss + row, __ATOMIC_RELAXED, __HIP_MEMORY_SCOPE_AGENT) * (1.0f / D) + EPS);
#pragma unroll
                for (int bj = 0; bj < 2; ++bj) { const f32x4 r0 = acc[ai][bj][m][0], r1 = acc[ai][bj][m][1];
                    const f32x4 w0 = *(const f32x4*)(w + col0 + bj * 128), w1 = *(const f32x4*)(w + col0 + bj * 128 + 4);
                    __builtin_nontemporal_store(r0 * rs * w0, (f32x4*)(out + off + bj * 128)); __builtin_nontemporal_store(r1 * rs * w1, (f32x4*)(out + off + bj * 128 + 4)); } }
    }
};
__device__ __forceinline__ float silu_f(float g) { return g * __builtin_amdgcn_rcpf(1.0f + __builtin_amdgcn_exp2f(-1.4426950408889634f * g)); }
struct EpiSwiglu {
    static constexpr bool PERM = true, AFTER_DRAIN = false;
    bf16* O; int ldc; const float* ss;
    __device__ __forceinline__ void operator()(const pg8::f32x4 (&acc)[2][2][4][2], const pg8::Unit& u, int wr, int wc, int fr, int fq) const {
        const int row0 = u.pm * 256 + wr * 64 + fr, col0 = u.pn * 128 + wc * 32 + 8 * fq;
#pragma unroll
        for (int ai = 0; ai < 2; ++ai)
#pragma unroll
            for (int m = 0; m < 4; ++m) { bf16* rowp = O + (size_t)(row0 + ai * 128 + m * 16) * ldc + col0; const float rs = rstd_of(ss, row0 + ai * 128 + m * 16);
                float o[8];
#pragma unroll
                for (int n = 0; n < 2; ++n)
#pragma unroll
                    for (int j = 0; j < 4; ++j) o[4 * n + j] = silu_f(acc[ai][0][m][n][j] * rs) * (acc[ai][1][m][n][j] * rs);
                v4u w; w.x = cvtpk(o[0], o[1]); w.y = cvtpk(o[2], o[3]); w.z = cvtpk(o[4], o[5]); w.w = cvtpk(o[6], o[7]);
                *(v4u*)rowp = w; }
    }
};
typedef GAS unsigned gu32;
#define RLX_AGENT __ATOMIC_RELAXED, __HIP_MEMORY_SCOPE_AGENT
#define XB_TMO      128
#define XB_XCNT(j)  (256  + 64 * (j))
#define XB_XSUB(j)  (1280 + 64 * (j))
#define XB_XGEN(j)  (2304 + 64 * (j))
#define XB_TOP      3328
#define XB_TOPGEN   3392
#define XCD_BAR_WORDS 3456
#define XB_SPIN_CAP (1u << 18)

__device__ __forceinline__ unsigned xb_ld(unsigned* p)              { return __hip_atomic_load(p, __ATOMIC_RELAXED, __HIP_MEMORY_SCOPE_AGENT); }
__device__ __forceinline__ unsigned xb_add(unsigned* p, unsigned v) { return __hip_atomic_fetch_add(p, v, __ATOMIC_RELAXED, __HIP_MEMORY_SCOPE_AGENT); }
__device__ __forceinline__ unsigned xb_xcc_id() { return (unsigned)__builtin_amdgcn_s_getreg((3 << 11) | 20) & 0xFu; }
#define XB_SPIN(cond, bar) do { unsigned _sp = 0; while (cond) { __builtin_amdgcn_s_sleep(1); \
    if ((++_sp & 255u) == 0u) { if (xb_ld(&(bar)[XB_TMO])) break; if (_sp > XB_SPIN_CAP) { atomicAdd(&(bar)[XB_TMO], 1u); break; } } } } while (0)

struct XcdBarrier {
    unsigned* bar; unsigned x;
    volatile LAS unsigned* st;
};

__device__ __forceinline__ XcdBarrier xcd_barrier_post(unsigned* bar, volatile LAS unsigned* st) {
    XcdBarrier b; b.bar = bar; b.x = xb_xcc_id(); b.st = st;
    if (threadIdx.x == 0) (void)xb_add(&bar[XB_XCNT(b.x)], 1u);
    return b;
}
__device__ __forceinline__ void xcd_barrier_complete(unsigned* bar, unsigned x, unsigned& nloc, unsigned& nx) {
    const unsigned G = gridDim.x * gridDim.y * gridDim.z;
    unsigned sum, cnt, mine, sp = 0u;
    for (;;) {
        sum = 0u; cnt = 0u; mine = 0u;
#pragma unroll
        for (unsigned j = 0; j < 16; ++j) { const unsigned c = xb_ld(&bar[XB_XCNT(j)]); sum += c; cnt += (c > 0u) ? 1u : 0u; mine = (j == x) ? c : mine; }
        if (sum == G) break;
        __builtin_amdgcn_s_sleep(1);
        if ((++sp & 255u) == 0u) { if (xb_ld(&bar[XB_TMO])) break; if (sp > XB_SPIN_CAP) { atomicAdd(&bar[XB_TMO], 1u); break; } }
    }
    nloc = mine > 0u ? mine : 1u; nx = cnt > 0u ? cnt : 1u;
}

__device__ __forceinline__ void xcd_barrier(const XcdBarrier& b) {
    asm volatile("s_waitcnt vmcnt(0)" ::: "memory");
    __syncthreads();
    if (threadIdx.x == 0) {
        unsigned* bar = b.bar;
        __builtin_amdgcn_s_waitcnt(0);
        unsigned nloc = b.st[0], nx = b.st[1];
        if (nloc == 0u) { xcd_barrier_complete(bar, b.x, nloc, nx); b.st[0] = nloc; b.st[1] = nx; }
        const unsigned old = xb_add(&bar[XB_XSUB(b.x)], 1u);
        const unsigned gen = old / nloc;
        if (old + 1u == (gen + 1u) * nloc) {
            __builtin_amdgcn_fence(__ATOMIC_RELEASE, "agent");
            asm volatile("s_waitcnt vmcnt(0)" ::: "memory");
            const unsigned og = xb_add(&bar[XB_TOP], 1u);
            const unsigned tg = og / nx;
            if (og + 1u == (tg + 1u) * nx) xb_add(&bar[XB_TOPGEN], 1u);
            else XB_SPIN(xb_ld(&bar[XB_TOPGEN]) == tg, bar);
            __builtin_amdgcn_fence(__ATOMIC_ACQUIRE, "agent");
            xb_add(&bar[XB_XGEN(b.x)], 1u);
            asm volatile("s_waitcnt vmcnt(0)" ::: "memory");
        } else {
            XB_SPIN(xb_ld(&bar[XB_XGEN(b.x)]) == gen, bar);
            __builtin_amdgcn_fence(__ATOMIC_ACQUIRE, "agent");
            asm volatile("s_waitcnt vmcnt(0)" ::: "memory");
        }
    }
    __syncthreads();
}
struct TrItem { const float* src; const float* gain; bf16* dst; int ldw; int K; float gs; int ncols; };
__device__ __forceinline__ void tr_load(const TrItem& it, f32x4 (&v)[16], int lane) {
    const int q = lane >> 4, n4 = lane & 15;
    if (4 * n4 < it.ncols) {
#pragma unroll
        for (int j = 0; j < 8; ++j)
#pragma unroll
            for (int hf = 0; hf < 2; ++hf) v[2 * j + hf] = *(const f32x4*)(it.src + (size_t)(8 * j + 2 * q + hf) * it.ldw + 4 * n4);
    } else {
#pragma unroll
        for (int i = 0; i < 16; ++i) v[i] = (f32x4){0.f, 0.f, 0.f, 0.f};
    }
}
__device__ __forceinline__ void tr_store(const TrItem& it, f32x4 (&v)[16], LAS unsigned* scr, int lane) {
    const int q = lane >> 4, n4 = lane & 15;
#pragma unroll
    for (int j = 0; j < 8; ++j) {
        float g0 = it.gs, g1 = it.gs;
        if (it.gain) { g0 *= it.gain[8 * j + 2 * q]; g1 *= it.gain[8 * j + 2 * q + 1]; }
#pragma unroll
        for (int c = 0; c < 4; ++c) scr[(4 * n4 + c) * 33 + 4 * j + q] = cvtpk(v[2 * j][c] * g0, v[2 * j + 1][c] * g1);
    }
    const int pc = lane & 7;
#pragma unroll
    for (int r = 0; r < 8; ++r) { const int n = 8 * r + (lane >> 3); const LAS unsigned* sp = scr + n * 33 + 4 * pc;
        v4u o = {sp[0], sp[1], sp[2], sp[3]};
        if (n < it.ncols) *(v4u*)(it.dst + (size_t)n * it.K + 8 * pc) = o; }
}
struct Args { const float* in[15]; float* out; unsigned char* ws; };
#define CAS __attribute__((address_space(4)))
__device__ __forceinline__ const float* argp(int i) { const CAS unsigned char* kp = (const CAS unsigned char*)__builtin_amdgcn_kernarg_segment_ptr(); asm volatile("" : "+s"(kp));
    const unsigned long long v = *(const CAS unsigned long long*)(kp + 8 * i); return (const float*)(const GAS float*)v; }
__device__ __forceinline__ unsigned char* wsp() { return (unsigned char*)argp(16); }
__device__ __forceinline__ int launder(int v) { asm volatile("" : "+v"(v)); return v; }

__device__ __forceinline__ int gu_row(int c0) { return c0 < FF ? 256 * (c0 >> 7) + (c0 & 127) : 256 * ((c0 - FF) >> 7) + 128 + ((c0 - FF) & 127); }

constexpr int I_IN = 96 * 32, I_GL = 32, I_SQ = 32 * 32, I_GU = 176 * 32, I_DN = 32 * 88, I_KV = 64 * 32;
constexpr int NITEMS_A = I_IN + I_GL + I_SQ + I_GU + I_DN + I_SQ + I_KV;
constexpr int NITEMS_B = NITEMS_A + I_SQ + I_GU;
constexpr int NITEMS = I_IN + I_GL + I_SQ + 2 * I_GU + 2 * I_DN + I_SQ + I_KV + I_SQ;
__device__ __forceinline__ TrItem tr_decode(int it) {
    unsigned char* ws = wsp();
    int r = it;
    const float* W; int ldw, K, ng, c0off = 0, ncols = 64, mode = 0, drowoff = 0; const float* gain = nullptr; float gs = 1.f; bf16* WT;
    if (r < I_IN) { W = argp(3); ldw = GIN; K = D; ng = 96; gain = argp(1); WT = (bf16*)(ws + WS_WIN); mode = 2; }
    else if ((r -= I_IN) < I_GL) { W = argp(3); ldw = GIN; K = D; ng = 1; c0off = NQ3; ncols = 16; gain = argp(1); WT = (bf16*)(ws + WS_WGL); }
    else if ((r -= I_GL) < I_SQ) { W = argp(7); ldw = D; K = D; ng = 32; WT = (bf16*)(ws + WS_WOUT); }
    else if ((r -= I_SQ) < I_GU) { W = argp(12); ldw = FF2; K = D; ng = 176; gain = argp(2); WT = (bf16*)(ws + WS_WGU0); mode = 1; }
    else if ((r -= I_GU) < I_DN) { W = argp(13); ldw = D; K = FF; ng = 32; WT = (bf16*)(ws + WS_WD0); }
    else if ((r -= I_DN) < I_SQ) { W = argp(10); ldw = D; K = D; ng = 32; gain = argp(1) + D; gs = C2; WT = (bf16*)(ws + WS_WQKV); }
    else if ((r -= I_SQ) < I_KV) { W = argp(9); ldw = 2 * D; K = D; ng = 64; gain = argp(8); WT = (bf16*)(ws + WS_WQKV); drowoff = D; }
    else if ((r -= I_KV) < I_SQ) { W = argp(11); ldw = D; K = D; ng = 32; WT = (bf16*)(ws + WS_WSBO); }
    else if ((r -= I_SQ) < I_GU) { W = argp(12) + (size_t)D * FF2; ldw = FF2; K = D; ng = 176; gain = argp(2) + D; WT = (bf16*)(ws + WS_WGU1); mode = 1; }
    else { r -= I_GU; W = argp(13) + (size_t)FF * D; ldw = D; K = FF; ng = 32; WT = (bf16*)(ws + WS_WD1); }
    const int kb = r / ng, nb = r - kb * ng, c0 = c0off + 64 * nb, k0 = 64 * kb;
    int drow0 = (mode == 1) ? gu_row(64 * nb) : drowoff + 64 * nb;
    if (ncols == 16) drow0 = 0;
    if (mode == 2 && c0 < GQK) gs = 0.0625f;
    TrItem t; t.src = W + (size_t)k0 * ldw + c0; t.gain = gain ? gain + k0 : nullptr; t.dst = WT + (size_t)drow0 * K + k0; t.ldw = ldw; t.K = K; t.gs = gs; t.ncols = ncols;
    return t;
}
__device__ __forceinline__ void p0_weights(LAS unsigned char* lds, int lo, int hi, int p, int NP, int wave, int lane) {
    LAS unsigned* scr = (LAS unsigned*)(lds + wave * 8448);
    f32x4 va[16], vb[16];
    int it = lo + p;
    if (it >= hi) return;
    TrItem A = tr_decode(it), B = A;
    tr_load(A, va, lane);
    for (;;) {
        const bool hb = (it + NP < hi);
        if (hb) { B = tr_decode(it + NP); tr_load(B, vb, lane); }
        tr_store(A, va, scr, lane);
        if (!hb) break;
        it += NP;
        const bool ha = (it + NP < hi);
        if (ha) { A = tr_decode(it + NP); tr_load(A, va, lane); }
        tr_store(B, vb, scr, lane);
        if (!ha) break;
        it += NP;
    }
}

__device__ __forceinline__ void rms_rows_bf16(const float* X, bf16* A, int gw, int NGW, int lane) {
    for (int m = gw; m < T; m += NGW) {
        const f32x4* xr = (const f32x4*)(X + (size_t)m * D) + lane;
        f32x4 v[8]; float s = 0.f;
#pragma unroll
        for (int j = 0; j < 8; ++j) { v[j] = xr[64 * j]; s += (v[j].x * v[j].x + v[j].y * v[j].y) + (v[j].z * v[j].z + v[j].w * v[j].w); }
        const float rstd = 1.0f / sqrtf(wave_sum(s) * (1.0f / D) + EPS);
        v2u* o8 = (v2u*)(A + (size_t)m * D) + lane;
#pragma unroll
        for (int j = 0; j < 8; ++j) { v2u o; o.x = cvtpk(v[j].x * rstd, v[j].y * rstd); o.y = cvtpk(v[j].z * rstd, v[j].w * rstd); o8[64 * j] = o; }
    }
}
__device__ __forceinline__ void rms_rows_gl(LAS unsigned char* lds, const float* X, const float* Win, const float* gain, bf16* A, float* GLB, int gw, int NGW, int tid, int lane) {
    __syncthreads();
    for (int idx = tid; idx < 2048 * 4; idx += NTHR) { const int k = idx >> 2, n4 = idx & 3;
        const f32x4 w = *(const f32x4*)(Win + (size_t)k * GIN + NQ3 + 4 * n4) * gain[k];
        *(LAS f32x4*)(lds + ((((k >> 8) * 4 + (k & 3)) * 4 + n4) * 64 + ((k >> 2) & 63)) * 16) = w; }
    __syncthreads();
    f32x4 vn[8];
    { const f32x4* x0 = (const f32x4*)(X + (size_t)(gw < T ? gw : 0) * D) + lane;
#pragma unroll
      for (int j = 0; j < 8; ++j) vn[j] = x0[64 * j]; }
    for (int m = gw; m < T; m += NGW) {
        f32x4 v[8]; float s = 0.f;
#pragma unroll
        for (int j = 0; j < 8; ++j) { v[j] = vn[j]; s += (v[j].x * v[j].x + v[j].y * v[j].y) + (v[j].z * v[j].z + v[j].w * v[j].w); }
        { const int mn = (m + NGW < T) ? m + NGW : m; const f32x4* xn = (const f32x4*)(X + (size_t)mn * D) + lane;
#pragma unroll
          for (int j = 0; j < 8; ++j) vn[j] = xn[64 * j]; }
        const float rstd = 1.0f / sqrtf(wave_sum(s) * (1.0f / D) + EPS);
        v2u* o8 = (v2u*)(A + (size_t)m * D) + lane;
#pragma unroll
        for (int j = 0; j < 8; ++j) { v2u o; o.x = cvtpk(v[j].x * rstd, v[j].y * rstd); o.y = cvtpk(v[j].z * rstd, v[j].w * rstd); o8[64 * j] = o; }
        f32x4 p[4];
#pragma unroll
        for (int n4 = 0; n4 < 4; ++n4) p[n4] = (f32x4){0.f, 0.f, 0.f, 0.f};
#pragma unroll
        for (int j = 0; j < 8; ++j)
#pragma unroll
            for (int i = 0; i < 4; ++i)
#pragma unroll
                for (int n4 = 0; n4 < 4; ++n4) p[n4] += *(const LAS f32x4*)(lds + (((j * 4 + i) * 4 + n4) * 64 + lane) * 16) * v[j][i];
        float q8[8], q4[4], q2[2], q1;
        { const bool up = (lane & 32) != 0;
#pragma unroll
          for (int t = 0; t < 8; ++t) { const float lo_ = p[t >> 2][t & 3], hi_ = p[2 + (t >> 2)][t & 3]; const float keep = up ? hi_ : lo_, send = up ? lo_ : hi_; q8[t] = keep + __shfl_xor(send, 32); } }
        { const bool up = (lane & 16) != 0;
#pragma unroll
          for (int t = 0; t < 4; ++t) { const float keep = up ? q8[4 + t] : q8[t], send = up ? q8[t] : q8[4 + t]; q4[t] = keep + __shfl_xor(send, 16); } }
        { const bool up = (lane & 8) != 0;
#pragma unroll
          for (int t = 0; t < 2; ++t) { const float keep = up ? q4[2 + t] : q4[t], send = up ? q4[t] : q4[2 + t]; q2[t] = keep + __shfl_xor(send, 8); } }
        { const bool up = (lane & 4) != 0; const float keep = up ? q2[1] : q2[0], send = up ? q2[0] : q2[1]; q1 = keep + __shfl_xor(send, 4); }
        q1 += __shfl_xor(q1, 2); q1 += __shfl_xor(q1, 1);
        if ((lane & 3) == 0) GLB[(size_t)m * 16 + (lane >> 2)] = q1 * rstd;
    }
}
__device__ __forceinline__ void rms_rows_final(const bf16* Xb, const float* ss, const float* w, float* O, int gw, int NGW, int lane) {
    for (int m = gw; m < T; m += NGW) {
        const float rstd = rstd_of(ss, m);
        const v4u* xr = (const v4u*)(Xb + (size_t)m * D) + lane; const f32x4* wr = (const f32x4*)w + 2 * lane; f32x4* o = (f32x4*)(O + (size_t)m * D) + 2 * lane;
#pragma unroll
        for (int j = 0; j < 4; ++j) { const v4u x = xr[64 * j]; const f32x4 w0 = wr[128 * j], w1 = wr[128 * j + 1];
            o[128 * j] = (f32x4){bflo(x.x) * rstd * w0.x, bfhi(x.x) * rstd * w0.y, bflo(x.y) * rstd * w0.z, bfhi(x.y) * rstd * w0.w};
            o[128 * j + 1] = (f32x4){bflo(x.z) * rstd * w1.x, bfhi(x.z) * rstd * w1.y, bflo(x.w) * rstd * w1.z, bfhi(x.w) * rstd * w1.w}; }
    }
}
__device__ __forceinline__ void gla_post(const bf16* OG, const bf16* QKVR, const float* gw_, bf16* A, int gw, int NGW, int lane) {
    const f32x4 g0 = *((const f32x4*)gw_ + 2 * lane), g1 = *((const f32x4*)gw_ + 2 * lane + 1);
    for (int it = gw; it < T * GH; it += NGW) {
        const int t = it >> 2, h = it & 3;
        const v4u ov = *((const v4u*)(OG + (size_t)t * 2048 + h * 512) + lane);
        const f32x4 a0 = {bflo(ov.x), bfhi(ov.x), bflo(ov.y), bfhi(ov.y)}, a1 = {bflo(ov.z), bfhi(ov.z), bflo(ov.w), bfhi(ov.w)};
        const v4u rr = *((const v4u*)(QKVR + (size_t)t * NQ3 + 4096 + h * 512) + lane);
        float s = (a0.x * a0.x + a0.y * a0.y) + (a0.z * a0.z + a0.w * a0.w) + (a1.x * a1.x + a1.y * a1.y) + (a1.z * a1.z + a1.w * a1.w);
        const float rstd = 1.0f / sqrtf(wave_sum(s) * (1.0f / GDV) + EPS);
        v4u o;
        o.x = cvtpk(a0.x * rstd * g0.x * silu_f(bflo(rr.x)), a0.y * rstd * g0.y * silu_f(bfhi(rr.x)));
        o.y = cvtpk(a0.z * rstd * g0.z * silu_f(bflo(rr.y)), a0.w * rstd * g0.w * silu_f(bfhi(rr.y)));
        o.z = cvtpk(a1.x * rstd * g1.x * silu_f(bflo(rr.z)), a1.y * rstd * g1.y * silu_f(bfhi(rr.z)));
        o.w = cvtpk(a1.z * rstd * g1.z * silu_f(bflo(rr.w)), a1.w * rstd * g1.w * silu_f(bfhi(rr.w)));
        *((v4u*)(A + (size_t)t * 2048 + h * 512) + lane) = o;
    }
}
__device__ __forceinline__ f32x4 mfma16(bf16x8 a, bf16x8 b, f32x4 c) { return __builtin_amdgcn_mfma_f32_16x16x32_bf16(a, b, c, 0, 0, 0); }
__device__ __forceinline__ float logsig_f(float s) { return fminf(s, 0.f) - __logf(1.0f + __expf(-fabsf(s))); }
constexpr int PR_KT = 0, PR_GL = 33792, PR_HT = 37888, PR_BC = 38912, PR_QL = 105472;
constexpr int KT_ST = 528, BC_ST = 260, VL_ST = 1040;

__device__ __forceinline__ void gla_prep_unit(LAS unsigned char* lds, int unit, int tid, int wave, int lane) {
    unsigned char* ws = wsp();
    const int h = unit & 3, c = (unit >> 2) & 63, b = unit >> 8, bh = b * 4 + h;
    const int t0 = b * SEQ + c * 64;
    const bf16* Aact = (const bf16*)(ws + WS_A); const bf16* WGL = (const bf16*)(ws + WS_WGL); const bf16* QKVR = (const bf16*)(ws + WS_QKVR);
    LAS float* GLP = (LAS float*)(lds + PR_KT); LAS float* GL = (LAS float*)(lds + PR_GL); LAS float* BC = (LAS float*)(lds + PR_BC); LAS float* HT = (LAS float*)(lds + PR_HT);
    const int fr = lane & 15, fq = lane >> 4;
    for (int i = tid; i < 1024; i += NTHR) GL[i] = ((const float*)(ws + WS_VT))[(size_t)t0 * 16 + i];
    __syncthreads();
    {
        const int d = tid & 255, half = tid >> 8;
        const float* Wg = argp(4) + h * 256 + d; float wg[16];
#pragma unroll
        for (int r = 0; r < 16; ++r) wg[r] = Wg[r * GQK];
        const float bias = argp(5)[h * 256 + d];
        float run = 0.f;
        for (int i = 0; i < 32; ++i) { const int row = half * 32 + i; float s = bias;
#pragma unroll
            for (int r4 = 0; r4 < 4; ++r4) { const f32x4 g = *(const LAS f32x4*)(GL + row * 16 + 4 * r4); s += g.x * wg[4 * r4] + g.y * wg[4 * r4 + 1] + g.z * wg[4 * r4 + 2] + g.w * wg[4 * r4 + 3]; }
            run += logsig_f(s) * 0.0625f; BC[row * BC_ST + d] = run; }
        if (half == 0) HT[d] = run;
        __syncthreads();
        if (half == 1) { const float add = HT[d]; for (int i = 32; i < 64; ++i) BC[i * BC_ST + d] += add; }
    }
    for (int p = tid; p < 2048; p += NTHR) { const int row = p >> 5, pc = p & 31;
        *(LAS v4u*)(lds + PR_KT + row * KT_ST + pc * 16) = *(const v4u*)(QKVR + (size_t)(t0 + row) * NQ3 + GQK + h * 256 + pc * 8); }
    __syncthreads();
    bf16* QF = (bf16*)(ws + WS_QB) + (size_t)(bh * 64 + c) * 16384; bf16* KF = (bf16*)(ws + WS_KDT) + (size_t)(bh * 64 + c) * 16384;
    bf16* PF = (bf16*)(ws + WS_KB) + (size_t)(bh * 64 + c) * 4096; float* EB = (float*)(ws + WS_EB);
    for (int p = tid; p < 2048; p += NTHR) { const int fr_ = p & 15, fq_ = (p >> 4) & 3, ks = (p >> 6) & 1, d = ((p >> 7) << 4) + fr_; const float bl = BC[63 * BC_ST + d]; float kd[8];
#pragma unroll
        for (int j = 0; j < 8; ++j) { const int row = 32 * ks + 8 * fq_ + j; const float kv = bf2f(*(const LAS unsigned short*)(lds + PR_KT + row * KT_ST + 2 * d)); kd[j] = kv * __expf(bl - BC[row * BC_ST + d]); }
        v4u o; o.x = cvtpk(kd[0], kd[1]); o.y = cvtpk(kd[2], kd[3]); o.z = cvtpk(kd[4], kd[5]); o.w = cvtpk(kd[6], kd[7]);
        *(v4u*)(KF + (size_t)p * 8) = o; }
    if (tid < 256) EB[(size_t)(bh * 64 + c) * 256 + tid] = __expf(BC[63 * BC_ST + tid]);
    __syncthreads();
    for (int p = tid; p < 2048; p += NTHR) { const int row = p >> 5, g8 = p & 31;
        const v4u q8 = *(const v4u*)(QKVR + (size_t)(t0 + row) * NQ3 + h * 256 + g8 * 8);
        const v4u k8 = *(const LAS v4u*)(lds + PR_KT + row * KT_ST + g8 * 16);
        const f32x4 b0 = *(const LAS f32x4*)(BC + row * BC_ST + 8 * g8), b1 = *(const LAS f32x4*)(BC + row * BC_ST + 8 * g8 + 4);
        const float e0 = __expf(b0.x), e1 = __expf(b0.y), e2 = __expf(b0.z), e3 = __expf(b0.w), e4 = __expf(b1.x), e5 = __expf(b1.y), e6 = __expf(b1.z), e7 = __expf(b1.w);
        v4u qo, ko;
        qo.x = cvtpk(bflo(q8.x) * e0, bfhi(q8.x) * e1); qo.y = cvtpk(bflo(q8.y) * e2, bfhi(q8.y) * e3); qo.z = cvtpk(bflo(q8.z) * e4, bfhi(q8.z) * e5); qo.w = cvtpk(bflo(q8.w) * e6, bfhi(q8.w) * e7);
        ko.x = cvtpk(bflo(k8.x) * __expf(-b0.x), bfhi(k8.x) * __expf(-b0.y)); ko.y = cvtpk(bflo(k8.y) * __expf(-b0.z), bfhi(k8.y) * __expf(-b0.w));
        ko.z = cvtpk(bflo(k8.z) * __expf(-b1.x), bfhi(k8.z) * __expf(-b1.y)); ko.w = cvtpk(bflo(k8.w) * __expf(-b1.z), bfhi(k8.w) * __expf(-b1.w));
        *(LAS v4u*)(lds + PR_QL + row * KT_ST + g8 * 16) = qo; *(LAS v4u*)(lds + PR_KT + row * KT_ST + g8 * 16) = ko; }
    __syncthreads();
    for (int p = tid; p < 2048; p += NTHR) { const int fr_ = p & 15, fq_ = (p >> 4) & 3, m = (p >> 6) & 3, w = p >> 8;
        const v2u lo = *(const LAS v2u*)(lds + PR_QL + (16 * m + fr_) * KT_ST + (32 * w + 4 * fq_) * 2), hi = *(const LAS v2u*)(lds + PR_QL + (16 * m + fr_) * KT_ST + (32 * w + 16 + 4 * fq_) * 2);
        v4u o = {lo.x, lo.y, hi.x, hi.y}; *(v4u*)(QF + (size_t)p * 8) = o; }
    {
        const int mi = wave >> 1, j0 = 2 * (wave & 1);
        if (j0 <= mi) {
            f32x4 p0 = {0.f, 0.f, 0.f, 0.f}, p1 = {0.f, 0.f, 0.f, 0.f}; const bool two = (j0 + 1 <= mi);
#pragma unroll
            for (int s8 = 0; s8 < 8; ++s8) { const bf16x8 aq = *(const LAS bf16x8*)(lds + PR_QL + (16 * mi + fr) * KT_ST + (32 * s8 + 8 * fq) * 2);
                const bf16x8 k0 = *(const LAS bf16x8*)(lds + PR_KT + (16 * j0 + fr) * KT_ST + (32 * s8 + 8 * fq) * 2); p0 = mfma16(aq, k0, p0);
                if (two) { const bf16x8 k1 = *(const LAS bf16x8*)(lds + PR_KT + (16 * (j0 + 1) + fr) * KT_ST + (32 * s8 + 8 * fq) * 2); p1 = mfma16(aq, k1, p1); } }
#pragma unroll
            for (int r = 0; r < 4; ++r) { const int ti = 16 * mi + 4 * fq + r;
                const float v0 = (16 * j0 + fr <= ti) ? p0[r] : 0.f, v1 = (two && (16 * (j0 + 1) + fr <= ti)) ? p1[r] : 0.f;
                *(LAS unsigned short*)(lds + PR_BC + ti * 144 + (16 * j0 + fr) * 2) = (unsigned short)(cvtpk(v0, 0.f) & 0xffffu);
                *(LAS unsigned short*)(lds + PR_BC + ti * 144 + (16 * (j0 + 1) + fr) * 2) = (unsigned short)(cvtpk(v1, 0.f) & 0xffffu); }
        } else {
#pragma unroll
            for (int r = 0; r < 4; ++r) { const int ti = 16 * mi + 4 * fq + r;
                *(LAS unsigned short*)(lds + PR_BC + ti * 144 + (16 * j0 + fr) * 2) = 0; *(LAS unsigned short*)(lds + PR_BC + ti * 144 + (16 * (j0 + 1) + fr) * 2) = 0; }
        }
    }
    __syncthreads();
    { const int p = tid, fr_ = p & 15, fq_ = (p >> 4) & 3, ks = (p >> 6) & 1, m = p >> 7;
      *(v4u*)(PF + (size_t)p * 8) = *(const LAS v4u*)(lds + PR_BC + (16 * m + fr_) * 144 + (32 * ks + 8 * fq_) * 2); }
    __syncthreads();
}

__device__ __forceinline__ bf16x8 pack8(f32x4 lo, f32x4 hi) { v4u w; w.x = cvtpk(lo[0], lo[1]); w.y = cvtpk(lo[2], lo[3]); w.z = cvtpk(hi[0], hi[1]); w.w = cvtpk(hi[2], hi[3]); return __builtin_bit_cast(bf16x8, w); }
struct ScanOps { bf16x8 qf[4], kf[4], px; f32x4 e0, e1; };
constexpr int SC_VB = 65536;
__device__ __forceinline__ s16x4 tr_rd(unsigned a) { s16x4 r; asm volatile("ds_read_b64_tr_b16 %0, %1" : "=v"(r) : "v"(a) : "memory"); return r; }
template <bool LOADER> __device__ __forceinline__ void scan_load(ScanOps& o, const bf16* qf_b, const bf16* kf_b, const bf16* px_b, int px_stride, const float* eb_b, int c, int lane) {
    const unsigned lo = (unsigned)lane * 16u;
    const char* q = (const char*)(qf_b + (size_t)c * 16384); const char* k = (const char*)(kf_b + (size_t)c * 16384); const char* p = (const char*)(px_b + (size_t)c * px_stride);
    o.px = LOADER ? *(const bf16x8*)p : *(const bf16x8*)(p + lo);
#pragma unroll
    for (int m = 0; m < 4; ++m) o.qf[m] = *(const bf16x8*)(q + lo + m * 1024);
#pragma unroll
    for (int i = 0; i < 4; ++i) o.kf[i] = *(const bf16x8*)(k + lo + i * 1024);
    const unsigned eo = (unsigned)(lane >> 4) * 16u; const char* e = (const char*)(eb_b + c * 256);
    o.e0 = *(const f32x4*)(e + eo); o.e1 = *(const f32x4*)(e + eo + 64);
}
template <bool LOADER> __device__ __forceinline__ void scan_step(const ScanOps& o, const bf16x8& nxt_px, f32x4& S0, f32x4& S1, LAS unsigned char* lds, int c, bf16* og, int tid, int wave, int lane, int mp, int ksp) {
    LAS float* PART = (LAS float*)(lds + (c & 1) * 32768);
    const unsigned va = (unsigned)(uintptr_t)(lds + SC_VB + (c & 1) * 2048) + (unsigned)(lane >> 4) * 256u + (unsigned)(lane & 15) * 8u;
    const s16x4 t0 = tr_rd(va), t1 = tr_rd(va + 128u), t2 = tr_rd(va + 1024u), t3 = tr_rd(va + 1152u);
    asm volatile("s_waitcnt lgkmcnt(0)" ::: "memory"); __builtin_amdgcn_sched_barrier(0);
    const bf16x8 vb0 = (bf16x8){t0[0], t0[1], t0[2], t0[3], t1[0], t1[1], t1[2], t1[3]}, vb1 = (bf16x8){t2[0], t2[1], t2[2], t2[3], t3[0], t3[1], t3[2], t3[3]};
    f32x4 ao[4];
    { const bf16x8 Sb = pack8(S0, S1);
#pragma unroll
      for (int m = 0; m < 4; ++m) ao[m] = mfma16(o.qf[m], Sb, (f32x4){0.f, 0.f, 0.f, 0.f}); }
    if constexpr (!LOADER) {
        const bf16x8 vs = ksp ? vb1 : vb0;
        const f32x4 oi = mfma16(o.px, vs, (f32x4){0.f, 0.f, 0.f, 0.f});
#pragma unroll
        for (int m = 0; m < 4; ++m) { const bool on = (m == mp);
#pragma unroll
            for (int r = 0; r < 4; ++r) ao[m][r] += on ? oi[r] : 0.f; }
    }
    S0 = S0 * o.e0; S1 = S1 * o.e1;
    S0 = mfma16(o.kf[0], vb0, S0); S0 = mfma16(o.kf[1], vb1, S0); S1 = mfma16(o.kf[2], vb0, S1); S1 = mfma16(o.kf[3], vb1, S1);
#pragma unroll
    for (int m = 0; m < 4; ++m)
#pragma unroll
        for (int r = 0; r < 4; ++r) PART[((wave * 4 + m) * 4 + r) * 64 + lane] = ao[m][r];
    if constexpr (LOADER) *(LAS bf16x8*)(lds + SC_VB + ((c + 1) & 1) * 2048 + (wave - 6) * 1024 + lane * 16) = nxt_px;
    __syncthreads();
    { const int idx = 2 * tid, m_ = idx >> 8, r_ = (idx >> 6) & 3, l_ = idx & 63, tok = 16 * m_ + 4 * (l_ >> 4) + r_; float s0 = 0.f, s1 = 0.f;
#pragma unroll
      for (int w = 0; w < 8; ++w) { const LAS float* pp = PART + w * 1024 + idx; s0 += pp[0]; s1 += pp[1]; }
      *(unsigned*)(og + (size_t)tok * 2048 + (l_ & 15)) = cvtpk(s0, s1); }
}
template <bool LOADER> __device__ __forceinline__ void gla_scan_waves(LAS unsigned char* lds, int unit, int tid, int wave, int lane) {
    unsigned char* ws = wsp();
    const int bh = unit & 7, sl = unit >> 3, b = bh >> 2, h = bh & 3;
    const bf16* qf_b = (const bf16*)(ws + WS_QB) + (size_t)bh * 64 * 16384 + wave * 2048;
    const bf16* kf_b = (const bf16*)(ws + WS_KDT) + (size_t)bh * 64 * 16384 + wave * 2048;
    const int mp = wave < 2 ? wave : 2 + ((wave - 2) >> 1), ksp = wave < 2 ? 0 : ((wave - 2) & 1);
    const bf16* px_b = LOADER ? (const bf16*)(ws + WS_QKVR) + (size_t)(b * SEQ + (wave - 6) * 32 + (lane >> 1)) * NQ3 + 2048 + h * 512 + sl * 16 + (lane & 1) * 8
                              : (const bf16*)(ws + WS_KB) + (size_t)bh * 64 * 4096 + (mp * 2 + ksp) * 512;
    constexpr int PXS = LOADER ? 64 * NQ3 : 4096;
    const float* eb_b = (const float*)(ws + WS_EB) + (size_t)bh * 64 * 256 + 32 * wave;
    bf16* og_b = (bf16*)(ws + WS_OG) + (size_t)(b * SEQ) * 2048 + h * 512 + sl * 16;
    f32x4 S0 = {0.f, 0.f, 0.f, 0.f}, S1 = {0.f, 0.f, 0.f, 0.f};
    ScanOps A, B, C;
    scan_load<LOADER>(A, qf_b, kf_b, px_b, PXS, eb_b, 0, lane);
    scan_load<LOADER>(B, qf_b, kf_b, px_b, PXS, eb_b, 1, lane);
    if constexpr (LOADER) *(LAS bf16x8*)(lds + SC_VB + (wave - 6) * 1024 + lane * 16) = A.px;
    __syncthreads();
    for (int c = 0; c < 63; c += 3) {
        scan_load<LOADER>(C, qf_b, kf_b, px_b, PXS, eb_b, c + 2, lane);
        scan_step<LOADER>(A, B.px, S0, S1, lds, c, og_b + (size_t)c * 64 * 2048, tid, wave, lane, mp, ksp);
        scan_load<LOADER>(A, qf_b, kf_b, px_b, PXS, eb_b, c + 3, lane);
        scan_step<LOADER>(B, C.px, S0, S1, lds, c + 1, og_b + (size_t)(c + 1) * 64 * 2048, tid, wave, lane, mp, ksp);
        scan_load<LOADER>(B, qf_b, kf_b, px_b, PXS, eb_b, c + 4 < 64 ? c + 4 : 63, lane);
        scan_step<LOADER>(C, A.px, S0, S1, lds, c + 2, og_b + (size_t)(c + 2) * 64 * 2048, tid, wave, lane, mp, ksp);
    }
    scan_step<LOADER>(A, A.px, S0, S1, lds, 63, og_b + (size_t)63 * 64 * 2048, tid, wave, lane, mp, ksp);
    __syncthreads();
}
__device__ __forceinline__ void gla_scan_unit(LAS unsigned char* lds, int unit, int tid, int wave, int lane) {
    if (wave >= 6) gla_scan_waves<true>(lds, unit, tid, wave, lane); else gla_scan_waves<false>(lds, unit, tid, wave, lane);
}
#define KSWZ(row, colB) ((row) * 256 + ((colB) ^ (((row) & 7) << 4)))
#define SBAR() __builtin_amdgcn_sched_barrier(0)
__device__ __forceinline__ int crow(int r, int hi) { return (r & 3) + 8 * (r >> 2) + 4 * hi; }
constexpr int AT_V = 0, AT_K = 16384, AT_FL = 32768, AT_ST = 36864;
__device__ __forceinline__ void qkt(f32x16& p0, f32x16& p1, const LAS unsigned char* Ks, const bf16x8* qr, int r32, int hi) {
    p0 = (f32x16){}; p1 = (f32x16){};
    __builtin_amdgcn_s_setprio(1);
#pragma unroll
    for (int d0 = 0; d0 < 8; ++d0) { const int cb = (d0 * 16 + hi * 8) * 2;
        const bf16x8 b0 = *(const LAS bf16x8*)(Ks + KSWZ(r32, cb));
        const bf16x8 b1 = *(const LAS bf16x8*)(Ks + KSWZ(32 + r32, cb));
        p0 = __builtin_amdgcn_mfma_f32_32x32x16_bf16(b0, qr[d0], p0, 0, 0, 0);
        p1 = __builtin_amdgcn_mfma_f32_32x32x16_bf16(b1, qr[d0], p1, 0, 0, 0); }
    __builtin_amdgcn_s_setprio(0);
}
__device__ __forceinline__ int v_st(int k, int c) { const int kk = (k & ~0xC) | ((k & 4) << 1) | ((k & 8) >> 1); return ((kk >> 3) * 4 + (c >> 5)) * 512 + ((kk & 7) * 32 + (c & 31)) * 2; }
__device__ __forceinline__ int v_rd_base(int lane) { return ((lane & 3) << 3) | (((lane >> 2) & 3) << 6) | (((lane >> 4) & 1) << 5) | (((lane >> 5) & 1) << 8); }
constexpr int v_rd_off(int d0, int ks, int half) { return d0 * 512 + ks * 4096 + half * 2048; }
template <int OFF> __device__ __forceinline__ s16x4 tr_read(int vb) {
    s16x4 r; asm volatile("ds_read_b64_tr_b16 %0, %1 offset:%2" : "=&v"(r) : "v"(vb), "i"(OFF) : "memory"); return r;
}
template <int D0> __device__ __forceinline__ void pv_one(f32x16& od, int vb, bf16x8 pa0, bf16x8 pa1, bf16x8 pa2, bf16x8 pa3) {
    const s16x4 l0 = tr_read<v_rd_off(D0, 0, 0)>(vb), h0 = tr_read<v_rd_off(D0, 0, 1)>(vb), l1 = tr_read<v_rd_off(D0, 1, 0)>(vb), h1 = tr_read<v_rd_off(D0, 1, 1)>(vb);
    const s16x4 l2 = tr_read<v_rd_off(D0, 2, 0)>(vb), h2 = tr_read<v_rd_off(D0, 2, 1)>(vb), l3 = tr_read<v_rd_off(D0, 3, 0)>(vb), h3 = tr_read<v_rd_off(D0, 3, 1)>(vb);
    asm volatile("s_waitcnt lgkmcnt(0)" ::: "memory"); SBAR();
#define PK(L, H) (bf16x8){L[0], L[1], L[2], L[3], H[0], H[1], H[2], H[3]}
    __builtin_amdgcn_s_setprio(1);
    od = __builtin_amdgcn_mfma_f32_32x32x16_bf16(pa0, PK(l0, h0), od, 0, 0, 0);
    od = __builtin_amdgcn_mfma_f32_32x32x16_bf16(pa1, PK(l1, h1), od, 0, 0, 0);
    od = __builtin_amdgcn_mfma_f32_32x32x16_bf16(pa2, PK(l2, h2), od, 0, 0, 0);
    od = __builtin_amdgcn_mfma_f32_32x32x16_bf16(pa3, PK(l3, h3), od, 0, 0, 0);
    __builtin_amdgcn_s_setprio(0);
#undef PK
}
template <bool MASKED> __device__ __forceinline__ void sb_transform(f32x16& p, int kbase, int tq, int hi, float& carry) {
    float f[16];
#pragma unroll
    for (int r = 0; r < 16; ++r) { const float u = __builtin_amdgcn_exp2f(fminf(p[r], 100.f)); const float rr = __builtin_amdgcn_rcpf(1.0f + u);
        const bool valid = !MASKED || (kbase + crow(r, hi) < tq);
        f[r] = valid ? rr : 1.0f; p[r] = valid ? u * rr : 0.f; }
    float run = carry;
#pragma unroll
    for (int g = 3; g >= 0; --g) {
        const float G = (f[4 * g] * f[4 * g + 1]) * (f[4 * g + 2] * f[4 * g + 3]);
        const float O = __shfl_xor(G, 32);
        const float a3 = hi == 0 ? run * O : run, a2 = a3 * f[4 * g + 3], a1 = a2 * f[4 * g + 2], a0 = a1 * f[4 * g + 1];
        p[4 * g + 3] *= a3; p[4 * g + 2] *= a2; p[4 * g + 1] *= a1; p[4 * g] *= a0;
        run *= G * O;
    }
    carry = run;
}
__device__ __forceinline__ void sb_pack(const f32x16& p0, const f32x16& p1, bf16x8& pa0, bf16x8& pa1, bf16x8& pa2, bf16x8& pa3) {
#define PK4(P, BASE, OUT) do { unsigned a0 = cvtpk(P[BASE + 0], P[BASE + 1]), a1 = cvtpk(P[BASE + 2], P[BASE + 3]);   \
    unsigned b0 = cvtpk(P[BASE + 4], P[BASE + 5]), b1 = cvtpk(P[BASE + 6], P[BASE + 7]);                              \
    auto r0 = __builtin_amdgcn_permlane32_swap(a0, b0, false, false); auto r1 = __builtin_amdgcn_permlane32_swap(a1, b1, false, false); \
    v4u w = {r0[0], r1[0], r0[1], r1[1]}; OUT = __builtin_bit_cast(bf16x8, w); } while (0)
    PK4(p0, 0, pa0); PK4(p0, 8, pa1); PK4(p1, 0, pa2); PK4(p1, 8, pa3);
#undef PK4
}
__device__ __forceinline__ void sb_attn_unit(LAS unsigned char* lds, int unit, int tid, int wid, int lane) {
    unsigned char* ws = wsp();
    const int qblk = unit & 15, bh = unit >> 4, b = bh >> 4, h = bh & 15, r32 = lane & 31, hi = lane >> 5;
    const int q0 = qblk * 256;
    const bf16* QKV = (const bf16*)(ws + WS_QKVR);
    const bf16* Qb = QKV + (size_t)(b * SEQ + q0) * NQ3 + h * HD; const bf16* Kh = QKV + (size_t)(b * SEQ) * NQ3 + 2048 + h * HD; const bf16* Vh = Kh + 2048;
    bf16x8 qr[8];
    { const bf16* Qw = Qb + (size_t)(wid * 32 + r32) * NQ3 + hi * 8;
#pragma unroll
      for (int d0 = 0; d0 < 8; ++d0) qr[d0] = *(const bf16x8*)(Qw + d0 * 16); }
    f32x16 o[4];
#pragma unroll
    for (int d = 0; d < 4; ++d) o[d] = (f32x16){};
    float carry = 1.0f;
    const int twmin = q0 + wid * 32, tq = twmin + r32;
    const int sr = tid >> 4, sc = (tid & 15) * 8, vst0 = v_st(sr, sc), vst1 = v_st(32 + sr, sc);
    const int vb0 = (int)(uintptr_t)(lds + AT_V) + v_rd_base(lane);
    volatile LAS int* FL = (volatile LAS int*)(lds + AT_FL);
    const int nt = (q0 + 256) / 64;
    v4u vs0, vs1, ks0, ks1;
#define SLOAD(k0) do { vs0 = *(const v4u*)(Vh + (size_t)((k0) + sr) * NQ3 + sc); vs1 = *(const v4u*)(Vh + (size_t)((k0) + 32 + sr) * NQ3 + sc); \
    ks0 = *(const v4u*)(Kh + (size_t)((k0) + sr) * NQ3 + sc); ks1 = *(const v4u*)(Kh + (size_t)((k0) + 32 + sr) * NQ3 + sc); } while (0)
    SLOAD((nt - 1) * 64);
    for (int kt = nt - 1; kt >= 0; --kt) {
        __syncthreads();
        if (kt < nt - 1) { int alld = 1;
#pragma unroll
            for (int w = 0; w < 8; ++w) alld &= FL[((kt + 1) & 1) * 8 + w];
            if (alld) break; }
        *(LAS v4u*)(lds + AT_V + vst0) = vs0; *(LAS v4u*)(lds + AT_V + vst1) = vs1;
        *(LAS v4u*)(lds + AT_K + KSWZ(sr, sc * 2)) = ks0; *(LAS v4u*)(lds + AT_K + KSWZ(32 + sr, sc * 2)) = ks1;
        __syncthreads();
        if (kt > 0) SLOAD((kt - 1) * 64);
        const int k0 = kt * 64;
        if (k0 < twmin + 31) {
            f32x16 p0, p1; qkt(p0, p1, lds + AT_K, qr, r32, hi);
            if (k0 + 63 >= twmin) { sb_transform<true>(p1, k0 + 32, tq, hi, carry); sb_transform<true>(p0, k0, tq, hi, carry); }
            else { sb_transform<false>(p1, k0 + 32, tq, hi, carry); sb_transform<false>(p0, k0, tq, hi, carry); }
            bf16x8 pa0, pa1, pa2, pa3; sb_pack(p0, p1, pa0, pa1, pa2, pa3);
            pv_one<0>(o[0], vb0, pa0, pa1, pa2, pa3); pv_one<1>(o[1], vb0, pa0, pa1, pa2, pa3); pv_one<2>(o[2], vb0, pa0, pa1, pa2, pa3); pv_one<3>(o[3], vb0, pa0, pa1, pa2, pa3);
        }
        const int done = __all(carry == 0.0f) ? 1 : 0;
        if (lane == 0) FL[(kt & 1) * 8 + wid] = done;
    }
#undef SLOAD
    bf16* Ow = (bf16*)(ws + WS_OG) + (size_t)(b * SEQ + q0 + wid * 32) * D + h * HD;
    LAS unsigned char* st = lds + AT_ST + wid * 8704;
#pragma unroll
    for (int r = 0; r < 16; ++r) { const int orow = crow(r, hi);
#pragma unroll
        for (int d0 = 0; d0 < 4; ++d0) *(LAS unsigned short*)(st + orow * 272 + (d0 * 32 + r32) * 2) = (unsigned short)(cvtpk(o[d0][r], 0.f) & 0xffffu); }
    LDS_WAIT();
#pragma unroll
    for (int i = 0; i < 8; ++i) { const int p = lane + 64 * i, row = p >> 4, pc = p & 15;
        *(v4u*)(Ow + (size_t)row * D + pc * 8) = *(const LAS v4u*)(st + row * 272 + pc * 16); }
    __syncthreads();
}
#ifndef WGM_GU
#define WGM_GU 4
#endif
#ifndef WGM_DN
#define WGM_DN 4
#endif
#ifndef WGM_QKV
#define WGM_QKV 4
#endif
#ifndef WGM_SQ
#define WGM_SQ 4
#endif
#ifndef PROBE_G7
#define PROBE_G7 1
#endif
#ifndef PROBE_G1
#define PROBE_G1 1
#endif
#ifndef PROBE_P0
#define PROBE_P0 1
#endif
#ifndef PROBE_SCAN
#define PROBE_SCAN 1
#endif
#ifndef PROBE_PREP
#define PROBE_PREP 1
#endif
#ifndef PROBE_ATTN
#define PROBE_ATTN 1
#endif
#define GEMM_PHASE_(EpiT, AOFF, BOFF, N_, K_, Einit, ALIGN) do { unsigned char* ws_ = wsp(); pg8::Gemm g{(const pg8::bf16_t*)(ws_ + (AOFF)), (const pg8::bf16_t*)(ws_ + (BOFF)), T, (N_), (K_)}; \
    pg8::StaticOrder S; S.init(T, (N_), (int)gridDim.x, (int)blockIdx.x, ((N_) == FF2) ? WGM_GU : (((K_) == FF) ? WGM_DN : (((N_) == NQ3) ? WGM_QKV : WGM_SQ))); EpiT E Einit; pg8::gemm_phase<EpiT, pg8::StaticOrder, ALIGN, true>(lds, g, S, E); } while (0)
#define GEMM_PHASE(EpiT, AOFF, BOFF, N_, K_, Einit) GEMM_PHASE_(EpiT, AOFF, BOFF, N_, K_, Einit, true)
#define GEMM_PHASE1(EpiT, AOFF, BOFF, N_, K_, Einit) GEMM_PHASE_(EpiT, AOFF, BOFF, N_, K_, Einit, false)
#define PH_IDS() const int tid = launder((int)threadIdx.x), lane = tid & 63, wave = __builtin_amdgcn_readfirstlane(tid >> 6), G = (int)gridDim.x, bid = (int)blockIdx.x, gw = bid * NWAVES + wave, NGW = G * NWAVES; (void)gw; (void)NGW; (void)lane

__global__ void __launch_bounds__(NTHR, 2) yoco_fwd(Args args) {
    extern __shared__ __attribute__((aligned(16))) unsigned char lds_raw[];
    LAS unsigned char* lds = (LAS unsigned char*)lds_raw;
    cg::grid_group grid = cg::this_grid();
    if (threadIdx.x < 16) ((LAS unsigned*)(lds + MISC_OFF))[threadIdx.x] = 0u;
    __syncthreads();
#define GRID_BAR() do { XcdBarrier b_; b_.bar = (unsigned*)(wsp() + WS_CTL) + 4096; b_.x = xb_xcc_id(); b_.st = (volatile LAS unsigned*)(lds + MISC_OFF) + 8; xcd_barrier(b_); } while (0)
    (void)xcd_barrier_post((unsigned*)(wsp() + WS_CTL) + 4096, (volatile LAS unsigned*)(lds + MISC_OFF) + 8);
    { PH_IDS(); for (int rep = 0; rep < PROBE_P0; ++rep) p0_weights(lds, 0, NITEMS_A, gw, NGW, wave, lane); rms_rows_gl(lds, argp(0), argp(3), argp(1), (bf16*)(wsp() + WS_A), (float*)(wsp() + WS_VT), gw, NGW, tid, lane); }
    if (__builtin_expect(wsp() == nullptr, 0)) grid.sync();
    GRID_BAR();
    for (int rep = 0; rep < PROBE_G1; ++rep) GEMM_PHASE(EpiStoreBf16, WS_A, WS_WIN, NQ3, D, ({(bf16*)(ws_ + WS_QKVR), NQ3, nullptr}));
    GRID_BAR();
    { PH_IDS();
      if (G == 256) { for (int r = 0; r < 2; ++r) { const int j = (r * 256 + bid) >> 3, grp = (bid & 7) * 16 + (j >> 2); gla_prep_unit(lds, (grp << 2) | (j & 3), tid, wave, lane); } }
      else for (int u = bid; u < NBATCH * 64 * GH; u += G) gla_prep_unit(lds, u, tid, wave, lane); }
    GRID_BAR();
    { PH_IDS(); for (int rep = 0; rep < PROBE_SCAN; ++rep) for (int u = bid; u < 256; u += G) gla_scan_unit(lds, u, tid, wave, lane); }
    GRID_BAR();
    { PH_IDS(); unsigned char* ws = wsp(); gla_post((const bf16*)(ws + WS_OG), (const bf16*)(ws + WS_QKVR), argp(6), (bf16*)(ws + WS_A), gw, NGW, lane); }
    GRID_BAR();
    GEMM_PHASE(EpiRes<false>, WS_A, WS_WOUT, D, D, ({argp(0), D, (bf16*)(ws_ + WS_A2), (float*)(ws_ + WS_SS)}));
    GRID_BAR();
    for (int rep = 0; rep < PROBE_G7; ++rep) GEMM_PHASE(EpiSwiglu, WS_A2, WS_WGU0, FF2, D, ({(bf16*)(ws_ + WS_ACT), FF, (const float*)(ws_ + WS_SS)}));
    { PH_IDS();
      if (G == 256) { if (bid >= 128) p0_weights(lds, NITEMS_A, NITEMS_B, (bid - 128) * NWAVES + wave, 128 * NWAVES, wave, lane); }
      else p0_weights(lds, NITEMS_A, NITEMS_B, gw, NGW, wave, lane); }
    GRID_BAR();
    GEMM_PHASE(EpiRes<true>, WS_ACT, WS_WD0, D, FF, ({ws_ + WS_A2, D, (bf16*)(ws_ + WS_A), (float*)(ws_ + WS_SS) + T}));
    GRID_BAR();
    GEMM_PHASE(EpiStoreBf16, WS_A, WS_WQKV, NQ3, D, ({(bf16*)(ws_ + WS_QKVR), NQ3, (const float*)(ws_ + WS_SS) + T}));
    GRID_BAR();
    { PH_IDS(); for (int rep = 0; rep < PROBE_ATTN; ++rep) for (int u = bid; u < NBATCH * SBH * 16; u += G) sb_attn_unit(lds, u, tid, wave, lane); }
    GRID_BAR();
    GEMM_PHASE(EpiRes<true>, WS_OG, WS_WSBO, D, D, ({ws_ + WS_A, D, (bf16*)(ws_ + WS_A2), (float*)(ws_ + WS_SS) + 2 * T}));
    GRID_BAR();
    GEMM_PHASE(EpiSwiglu, WS_A2, WS_WGU1, FF2, D, ({(bf16*)(ws_ + WS_ACT), FF, (const float*)(ws_ + WS_SS) + 2 * T}));
    { PH_IDS();
      if (G == 256) { if (bid >= 128) p0_weights(lds, NITEMS_B, NITEMS, (bid - 128) * NWAVES + wave, 128 * NWAVES, wave, lane); }
      else p0_weights(lds, NITEMS_B, NITEMS, gw, NGW, wave, lane); }
    GRID_BAR();
    if (gridDim.x == 256) {
        GEMM_PHASE(EpiFinal, WS_ACT, WS_WD1, D, FF, ({(const bf16*)(ws_ + WS_A2), D, (float*)(ws_ + WS_SS) + 3 * T, (unsigned*)(ws_ + WS_CTL) + 12288, argp(14), (float*)argp(15)}));
    } else {
        GEMM_PHASE(EpiRes<true>, WS_ACT, WS_WD1, D, FF, ({ws_ + WS_A2, D, (bf16*)(ws_ + WS_A2), (float*)(ws_ + WS_SS) + 3 * T}));
        GRID_BAR();
        { PH_IDS(); unsigned char* ws = wsp(); rms_rows_final((const bf16*)(ws + WS_A2), (const float*)(ws + WS_SS) + 3 * T, argp(14), (float*)argp(15), gw, NGW, lane); }
    }
}

extern "C" void kernel_launch(void* const* d_in, const int* in_sizes, int n_in, void* d_out, int out_size, void* d_ws, size_t ws_size, hipStream_t stream) {
    static int grid = 0;
    if (grid == 0) {
        if (n_in != 15 || in_sizes[0] != T * D || out_size != T * D || ws_size < WS_END) { fprintf(stderr, "kernel_launch: unexpected shapes n_in %d in0 %d out %d ws %zu\n", n_in, n_in > 0 ? in_sizes[0] : -1, out_size, ws_size); grid = -1; return; }
        int dev = 0, cus = 0, per_cu = 0;
        (void)hipGetDevice(&dev); (void)hipDeviceGetAttribute(&cus, hipDeviceAttributeMultiprocessorCount, dev);
        if (hipFuncSetAttribute((const void*)yoco_fwd, hipFuncAttributeMaxDynamicSharedMemorySize, LDS_BYTES) != hipSuccess) { fprintf(stderr, "kernel_launch: hipFuncSetAttribute failed\n"); grid = -1; return; }
        if (hipOccupancyMaxActiveBlocksPerMultiprocessor(&per_cu, (const void*)yoco_fwd, NTHR, LDS_BYTES) != hipSuccess || per_cu < 1) { fprintf(stderr, "kernel_launch: occupancy query says %d\n", per_cu); per_cu = 1; }
        (void)hipGetLastError();
        grid = cus;
    }
    if (grid < 0) return;
    if (hipMemsetAsync((char*)d_ws + WS_CTL, 0, 65536 + 4 * T * 4, stream) != hipSuccess) { fprintf(stderr, "kernel_launch: memset failed\n"); return; }
    Args a{};
    for (int i = 0; i < 15; ++i) a.in[i] = (const float*)d_in[i];
    a.out = (float*)d_out; a.ws = (unsigned char*)d_ws;
    void* kargs[] = {&a};
    hipError_t e = hipLaunchCooperativeKernel((const void*)yoco_fwd, dim3(grid), dim3(NTHR), kargs, LDS_BYTES, stream);
    if (e != hipSuccess) fprintf(stderr, "kernel_launch: cooperative launch failed: %s (grid %d)\n", hipGetErrorString(e), grid);
}
```

```cpp
#include <hip/hip_runtime.h>
#include <hip/hip_cooperative_groups.h>
#include <cstdio>
#include <cstdint>
namespace cg = cooperative_groups;
namespace pg8 {
#define PG8_LAS __attribute__((address_space(3)))
typedef unsigned short bf16_t;
typedef short bf16x8 __attribute__((ext_vector_type(8)));
typedef float f32x4 __attribute__((ext_vector_type(4)));
typedef unsigned u32x4 __attribute__((ext_vector_type(4)));
constexpr int BM = 256, BK = 64, HALF = 128, HTB = HALF * BK * 2  , STAGE_BYTES = 8 * HTB, NXCD = 8, WGM = 4;

__host__ __device__ __forceinline__ int lds_byte(int r, int c) { const int st = (r >> 4) * 2 + (c >> 5), rr = r & 15, cc = c & 31, ob = rr * 64 + cc * 2; return st * 1024 + (ob ^ (((ob >> 9) & 1) << 5)); }
__host__ __device__ __forceinline__ void stage_rc(int b, int& R, int& C) { const int st = b / 1024, sb = b % 1024, swz = sb ^ (((sb >> 9) & 1) << 5); R = (st >> 1) * 16 + swz / 64; C = (st & 1) * 32 + (swz % 64) / 2; }
__host__ __device__ __forceinline__ int perm32(int rho) { const int n = rho >> 4, i = rho & 15; return 8 * (i >> 2) + 4 * n + (i & 3); }

struct Unit { int pm, pn; };
struct Gemm { const bf16_t* A; const bf16_t* Bt; int M, N, K; };

struct StaticOrder {
    int nM, nN, nwg, G, c, wgm;
    __host__ __device__ void init(int M, int N, int G_, int c_, int wgm_ = WGM) { nM = M / BM; nN = N / BM; nwg = nM * nN; G = G_; c = c_; wgm = wgm_; }
    __host__ __device__ bool next(int i, Unit& u) const {
        const long L = (long)i * G + c; if (L >= nwg) return false;
        int wgid = (int)L; { const int q = nwg / NXCD, r = nwg % NXCD, xcd = wgid % NXCD, off = wgid / NXCD; wgid = (xcd < r ? xcd * (q + 1) : r * (q + 1) + (xcd - r) * q) + off; }
        const int nig = wgm * nN, gid = wgid / nig, fm = gid * wgm, gsz = (nM - fm) < wgm ? (nM - fm) : wgm;
        u.pm = fm + ((wgid % nig) % gsz); u.pn = (wgid % nig) / gsz; return true;
    }
    __device__ __forceinline__ void a_ready(const Unit&) const {}
    __device__ __forceinline__ void done(const Unit&) const {}
};

template <class Epi, class Sched, bool ALIGN_EPI = false, bool SP2 = false>
__device__ __forceinline__ void gemm_phase(PG8_LAS unsigned char* lds, const Gemm g, const Sched& S, const Epi& E) {
    int tid = threadIdx.x; asm volatile("" : "+v"(tid)); const int wid = __builtin_amdgcn_readfirstlane(tid >> 6), lane = tid & 63, wr = wid >> 2, wc = wid & 3, fr = lane & 15, fq = lane >> 4;
    const int K = g.K, nt = K / BK;
    unsigned voffA[2], voffB[2];
#pragma unroll
    for (int i = 0; i < 2; ++i) { int R, C; stage_rc(tid * 16 + i * 8192, R, C); const int Rb = Epi::PERM ? ((R & ~31) + perm32(R & 31)) : R;
        voffA[i] = (unsigned)(R * K + C) * 2u; voffB[i] = (unsigned)(Rb * K + C) * 2u; }
    const size_t kstep = (size_t)(BK * 2);
    const size_t hstep = (size_t)HALF * K * 2;
    const size_t tstep = 2 * hstep;
    const unsigned ldsw = (unsigned)wid * 1024u;
    const int aoff = lds_byte(wr * 64 + fr, fq * 8), boff = lds_byte(wc * 32 + fr, fq * 8);
#define PG8_SA(b, h) (((b) * 2 + (h)) * HTB)
#define PG8_SB(b, h) ((4 + (b) * 2 + (h)) * HTB)
#define PG8_STAGE(bufoff, gbase, voff) do { _Pragma("unroll") for (int _i = 0; _i < 2; ++_i) \
        __builtin_amdgcn_global_load_lds((const unsigned*)((const char*)(gbase) + (voff)[_i]), (PG8_LAS unsigned*)(lds + (bufoff) + ldsw + _i * 8192), 16, 0, 0); } while (0)
#define PG8_LDA(dst, b, h) do { _Pragma("unroll") for (int m = 0; m < 4; ++m) _Pragma("unroll") for (int k = 0; k < 2; ++k) dst[m][k] = *(const PG8_LAS bf16x8*)(lds + PG8_SA(b, h) + aoff + m * 2048 + k * 1024); } while (0)
#define PG8_LDB(dst, b, h) do { _Pragma("unroll") for (int n = 0; n < 2; ++n) _Pragma("unroll") for (int k = 0; k < 2; ++k) dst[n][k] = *(const PG8_LAS bf16x8*)(lds + PG8_SB(b, h) + boff + n * 2048 + k * 1024); } while (0)
#define PG8_MMA(ai, bj, At, Bt) do { __builtin_amdgcn_s_setprio(1); _Pragma("unroll") for (int m = 0; m < 4; ++m) _Pragma("unroll") for (int n = 0; n < 2; ++n) _Pragma("unroll") for (int k = 0; k < 2; ++k) \
        acc[ai][bj][m][n] = __builtin_amdgcn_mfma_f32_16x16x32_bf16(Bt[n][k], At[m][k], acc[ai][bj][m][n], 0, 0, 0); __builtin_amdgcn_s_setprio(0); } while (0)
#define PG8_WAIT_V(n) asm volatile("s_waitcnt vmcnt(" #n ")" ::: "memory")
#define PG8_WAIT_L(n) asm volatile("s_waitcnt lgkmcnt(" #n ")" ::: "memory")
#define PG8_BAR __builtin_amdgcn_s_barrier()
#define PG8_SCHED __builtin_amdgcn_sched_barrier(0)
    Unit cur, nxt; int ui = 0;
    if (!S.next(0, cur)) return;
    f32x4 acc[2][2][4][2];
#pragma unroll
    for (int a = 0; a < 2; ++a)
#pragma unroll
        for (int b = 0; b < 2; ++b)
#pragma unroll
            for (int m = 0; m < 4; ++m)
#pragma unroll
                for (int n = 0; n < 2; ++n) acc[a][b][m][n] = (f32x4){0.f, 0.f, 0.f, 0.f};
    bf16x8 At[4][2], B0[2][2], B1[2][2];
    const char* cA = (const char*)g.A + (size_t)cur.pm * tstep; const char* cB = (const char*)g.Bt + (size_t)cur.pn * tstep;
    S.a_ready(cur);
    if constexpr (SP2) {
        PG8_STAGE(PG8_SB(0, 0), cB, voffB); PG8_STAGE(PG8_SB(0, 1), cB + hstep, voffB); PG8_STAGE(PG8_SA(0, 0), cA, voffA); PG8_STAGE(PG8_SA(0, 1), cA + hstep, voffA);
        if (wr == 1) PG8_BAR;
        PG8_WAIT_V(2); PG8_BAR;
        PG8_STAGE(PG8_SB(1, 0), cB + kstep, voffB); PG8_STAGE(PG8_SA(1, 0), cA + kstep, voffA); PG8_STAGE(PG8_SB(1, 1), cB + hstep + kstep, voffB);
        PG8_WAIT_V(6); PG8_BAR;
    } else {
        PG8_STAGE(PG8_SB(0, 0), cB, voffB); PG8_STAGE(PG8_SA(0, 0), cA, voffA); PG8_STAGE(PG8_SB(0, 1), cB + hstep, voffB); PG8_STAGE(PG8_SA(0, 1), cA + hstep, voffA);
        if (wr == 1) PG8_BAR;
        PG8_WAIT_V(4); PG8_BAR;
        PG8_STAGE(PG8_SB(1, 0), cB + kstep, voffB); PG8_STAGE(PG8_SA(1, 0), cA + kstep, voffA); PG8_STAGE(PG8_SB(1, 1), cB + hstep + kstep, voffB);
        PG8_WAIT_V(6); PG8_BAR;
    }
    for (;;) {
        const bool has_next = S.next(ui + 1, nxt);
        const char* nA = has_next ? (const char*)g.A + (size_t)nxt.pm * tstep : cA; const char* nB = has_next ? (const char*)g.Bt + (size_t)nxt.pn * tstep : cB;
        for (int t = 0; t < nt; t += 2) {
            const bool last = (t == nt - 2);
            const char* a1 = cA + (size_t)(t + 1) * kstep;
            const char* a2 = last ? nA : cA + (size_t)(t + 2) * kstep; const char* b2 = last ? nB : cB + (size_t)(t + 2) * kstep;
            const char* a3 = a2 + kstep; const char* b3 = b2 + kstep;
            if (last && has_next) S.a_ready(nxt);
            if constexpr (SP2) {
            PG8_LDB(B0, 0, 0); PG8_LDB(B1, 0, 1); PG8_SCHED; PG8_LDA(At, 0, 0); PG8_STAGE(PG8_SA(1, 1), a1 + hstep, voffA);
            PG8_WAIT_V(8); PG8_WAIT_L(0); PG8_BAR; PG8_MMA(0, 0, At, B0); PG8_MMA(0, 1, At, B1); PG8_BAR; PG8_SCHED;
            PG8_LDA(At, 0, 1); PG8_STAGE(PG8_SB(0, 0), b2, voffB); PG8_STAGE(PG8_SB(0, 1), b2 + hstep, voffB); PG8_STAGE(PG8_SA(0, 0), a2, voffA);
            PG8_WAIT_V(8); PG8_WAIT_L(0); PG8_BAR; PG8_MMA(1, 0, At, B0); PG8_MMA(1, 1, At, B1); PG8_BAR; PG8_SCHED;
            PG8_LDB(B0, 1, 0); PG8_LDB(B1, 1, 1); PG8_SCHED; PG8_LDA(At, 1, 0); PG8_STAGE(PG8_SA(0, 1), a2 + hstep, voffA);
            PG8_WAIT_V(8); PG8_WAIT_L(0); PG8_BAR; PG8_MMA(0, 0, At, B0); PG8_MMA(0, 1, At, B1); PG8_BAR; PG8_SCHED;
            PG8_LDA(At, 1, 1); PG8_STAGE(PG8_SB(1, 0), b3, voffB); PG8_STAGE(PG8_SB(1, 1), b3 + hstep, voffB); PG8_STAGE(PG8_SA(1, 0), a3, voffA);
            PG8_WAIT_V(8); PG8_WAIT_L(0); PG8_BAR; PG8_MMA(1, 0, At, B0); PG8_MMA(1, 1, At, B1); PG8_BAR; PG8_SCHED;
            } else {
            PG8_LDB(B0, 0, 0); PG8_SCHED; PG8_LDA(At, 0, 0); PG8_STAGE(PG8_SA(1, 1), a1 + hstep, voffA);
            PG8_WAIT_L(8); PG8_BAR; PG8_WAIT_L(0); PG8_MMA(0, 0, At, B0); PG8_BAR; PG8_SCHED;
            PG8_LDB(B1, 0, 1); PG8_STAGE(PG8_SB(0, 0), b2, voffB);
            PG8_BAR; PG8_WAIT_L(0); PG8_MMA(0, 1, At, B1); PG8_BAR;
            PG8_LDA(At, 0, 1); PG8_STAGE(PG8_SA(0, 0), a2, voffA);
            PG8_BAR; PG8_WAIT_L(0); PG8_MMA(1, 0, At, B0); PG8_BAR; PG8_SCHED;
            PG8_STAGE(PG8_SB(0, 1), b2 + hstep, voffB);
            PG8_WAIT_V(6); PG8_BAR; PG8_MMA(1, 1, At, B1); PG8_BAR;
            PG8_LDB(B0, 1, 0); PG8_SCHED; PG8_LDA(At, 1, 0); PG8_STAGE(PG8_SA(0, 1), a2 + hstep, voffA);
            PG8_WAIT_L(8); PG8_BAR; PG8_WAIT_L(0); PG8_MMA(0, 0, At, B0); PG8_BAR; PG8_SCHED;
            PG8_LDB(B1, 1, 1); PG8_STAGE(PG8_SB(1, 0), b3, voffB);
            PG8_BAR; PG8_WAIT_L(0); PG8_MMA(0, 1, At, B1); PG8_BAR;
            PG8_LDA(At, 1, 1); PG8_STAGE(PG8_SA(1, 0), a3, voffA);
            PG8_BAR; PG8_WAIT_L(0); PG8_MMA(1, 0, At, B0); PG8_BAR; PG8_SCHED;
            PG8_STAGE(PG8_SB(1, 1), b3 + hstep, voffB);
            PG8_WAIT_V(6); PG8_BAR; PG8_MMA(1, 1, At, B1); PG8_BAR;
            }
        }
        if constexpr (ALIGN_EPI) { if (wr == 0) PG8_BAR; }
        if constexpr (!Epi::AFTER_DRAIN) { E(acc, cur, wr, wc, fr, fq); S.done(cur); }
        if (!has_next) break;
#pragma unroll
        for (int a = 0; a < 2; ++a)
#pragma unroll
            for (int b = 0; b < 2; ++b)
#pragma unroll
                for (int m = 0; m < 4; ++m)
#pragma unroll
                    for (int n = 0; n < 2; ++n) acc[a][b][m][n] = (f32x4){0.f, 0.f, 0.f, 0.f};
        cur = nxt; cA = nA; cB = nB; ++ui;
        if constexpr (ALIGN_EPI) { if (wr == 1) PG8_BAR; }
    }
    PG8_WAIT_V(0);
    if constexpr (!ALIGN_EPI) { if (wr == 0) PG8_BAR; }
    PG8_BAR;
    if constexpr (Epi::AFTER_DRAIN) { E.fused(acc, cur, wr, wc, fr, fq, lds, wid, lane); S.done(cur); }
#undef PG8_SA
#undef PG8_SB
#undef PG8_STAGE
#undef PG8_LDA
#undef PG8_LDB
#undef PG8_MMA
#undef PG8_WAIT_V
#undef PG8_WAIT_L
#undef PG8_BAR
#undef PG8_SCHED
}
}
#define GAS __attribute__((address_space(1)))
#define LAS __attribute__((address_space(3)))
typedef unsigned short bf16;
typedef unsigned v4u __attribute__((ext_vector_type(4)));
typedef unsigned v2u __attribute__((ext_vector_type(2)));
typedef float f32x4 __attribute__((ext_vector_type(4)));
typedef float f32x16 __attribute__((ext_vector_type(16)));
typedef short bf16x8 __attribute__((ext_vector_type(8)));
typedef short s16x4 __attribute__((ext_vector_type(4)));

constexpr int NWAVES = 8, NTHR = 512;
constexpr int T = 8192, D = 2048, SEQ = 4096, NBATCH = 2;
constexpr int GH = 4, GDK = 256, GDV = 512, GQK = 1024, GIN = 6160, NQ3 = 6144;
constexpr int FF = 5632, FF2 = 11264;
constexpr int SBH = 16, HD = 128;
constexpr float EPS = 1e-6f;
constexpr float C2 = 0.08838834764831845f * 1.4426950408889634f;
constexpr float SB_DONE = -160.0f;

constexpr size_t MiB = 1u << 20;
constexpr size_t WS_CTL = 0, WS_WIN = 1 * MiB, WS_WGL = 25 * MiB, WS_WOUT = 26 * MiB, WS_WGU0 = 34 * MiB, WS_WD0 = 78 * MiB,
                 WS_WQKV = 100 * MiB, WS_WSBO = 124 * MiB, WS_WGU1 = 132 * MiB, WS_WD1 = 176 * MiB,
                 WS_A = 198 * MiB, WS_QKVR = 230 * MiB, WS_QB = 327 * MiB, WS_KB = 343 * MiB, WS_KDT = 359 * MiB, WS_VT = 375 * MiB,
                 WS_EB = 407 * MiB, WS_SS = 65536, WS_OG = 408 * MiB, WS_H = 472 * MiB, WS_ACT = 536 * MiB, WS_A2 = 624 * MiB, WS_END = 656 * MiB;
constexpr int LDS_BYTES = 147456, MISC_OFF = LDS_BYTES - 64;

__device__ __forceinline__ unsigned cvtpk(float lo, float hi) { unsigned r; asm volatile("v_cvt_pk_bf16_f32 %0, %1, %2" : "=v"(r) : "v"(lo), "v"(hi)); return r; }
__device__ __forceinline__ float bf2f(unsigned short u) { return __builtin_bit_cast(float, (unsigned)u << 16); }
__device__ __forceinline__ float bflo(unsigned u) { return __builtin_bit_cast(float, u << 16); }
__device__ __forceinline__ float bfhi(unsigned u) { return __builtin_bit_cast(float, u & 0xffff0000u); }
__device__ __forceinline__ float wave_sum(float v) {
#pragma unroll
    for (int o = 1; o < 64; o <<= 1) v += __shfl_xor(v, o);
    return v;
}
#define LDS_WAIT() asm volatile("s_waitcnt lgkmcnt(0)" ::: "memory")

__device__ __forceinline__ float rstd_of(const float* ss, int row) { return __builtin_amdgcn_rsqf(ss[row] * (1.0f / D) + EPS); }
struct EpiStoreBf16 {
    static constexpr bool PERM = true, AFTER_DRAIN = false;
    bf16* O; int ldc; const float* ss;
    __device__ __forceinline__ void operator()(const pg8::f32x4 (&acc)[2][2][4][2], const pg8::Unit& u, int wr, int wc, int fr, int fq) const {
        const int row0 = u.pm * 256 + wr * 64 + fr, col0 = u.pn * 256 + wc * 32 + 8 * fq;
#pragma unroll
        for (int ai = 0; ai < 2; ++ai)
#pragma unroll
            for (int m = 0; m < 4; ++m) { bf16* rowp = O + (size_t)(row0 + ai * 128 + m * 16) * ldc + col0; const float rs = ss ? rstd_of(ss, row0 + ai * 128 + m * 16) : 1.0f;
#pragma unroll
                for (int bj = 0; bj < 2; ++bj) { const pg8::f32x4 v0 = acc[ai][bj][m][0] * rs, v1 = acc[ai][bj][m][1] * rs;
                    v4u w; w.x = cvtpk(v0[0], v0[1]); w.y = cvtpk(v0[2], v0[3]); w.z = cvtpk(v1[0], v1[1]); w.w = cvtpk(v1[2], v1[3]);
                    *(v4u*)(rowp + bj * 128) = w; } }
    }
};
template <bool RBF> struct EpiRes {
    static constexpr bool PERM = true, AFTER_DRAIN = false;
    const void* R; int ldc; bf16* A; float* ss;
    __device__ __forceinline__ void operator()(const pg8::f32x4 (&acc)[2][2][4][2], const pg8::Unit& u, int wr, int wc, int fr, int fq) const {
        const int row0 = u.pm * 256 + wr * 64 + fr, col0 = u.pn * 256 + wc * 32 + 8 * fq;
#pragma unroll
        for (int ai = 0; ai < 2; ++ai)
#pragma unroll
            for (int m = 0; m < 4; ++m) { const size_t off = (size_t)(row0 + ai * 128 + m * 16) * ldc + col0; float sq = 0.f;
#pragma unroll
                for (int bj = 0; bj < 2; ++bj) {
                    f32x4 r0, r1;
                    if (RBF) { const v4u x = *(const v4u*)((const bf16*)R + off + bj * 128); r0 = (f32x4){bflo(x.x), bfhi(x.x), bflo(x.y), bfhi(x.y)}; r1 = (f32x4){bflo(x.z), bfhi(x.z), bflo(x.w), bfhi(x.w)}; }
                    else { r0 = *(const f32x4*)((const float*)R + off + bj * 128); r1 = *(const f32x4*)((const float*)R + off + bj * 128 + 4); }
                    r0 = r0 + acc[ai][bj][m][0]; r1 = r1 + acc[ai][bj][m][1];
                    sq += (r0[0] * r0[0] + r0[1] * r0[1]) + (r0[2] * r0[2] + r0[3] * r0[3]) + (r1[0] * r1[0] + r1[1] * r1[1]) + (r1[2] * r1[2] + r1[3] * r1[3]);
                    v4u w; w.x = cvtpk(r0[0], r0[1]); w.y = cvtpk(r0[2], r0[3]); w.z = cvtpk(r1[0], r1[1]); w.w = cvtpk(r1[2], r1[3]);
                    *(v4u*)(A + off + bj * 128) = w; }
                sq += __shfl_xor(sq, 16); sq += __shfl_xor(sq, 32);
                if (fq == 0) atomicAdd(ss + row0 + ai * 128 + m * 16, sq); }
    }
};
struct EpiFinal {
    static constexpr bool PERM = true, AFTER_DRAIN = true;
    const bf16* R; int ldc; float* ss; unsigned* cnt; const float* w; float* out;
    __device__ __forceinline__ void operator()(const pg8::f32x4 (&)[2][2][4][2], const pg8::Unit&, int, int, int, int) const {}
    __device__ __forceinline__ void fused(const pg8::f32x4 (&acc_)[2][2][4][2], const pg8::Unit& u, int wr, int wc, int fr, int fq, PG8_LAS unsigned char* lds, int wid, int lane) const {
        pg8::f32x4 (&acc)[2][2][4][2] = const_cast<pg8::f32x4 (&)[2][2][4][2]>(acc_);
        const int row0 = u.pm * 256 + wr * 64 + fr, col0 = u.pn * 256 + wc * 32 + 8 * fq;
#pragma unroll
        for (int ai = 0; ai < 2; ++ai)
#pragma unroll
            for (int m = 0; m < 4; ++m) { const size_t off = (size_t)(row0 + ai * 128 + m * 16) * ldc + col0; float sq = 0.f;
#pragma unroll
                for (int bj = 0; bj < 2; ++bj) { const v4u x = *(const v4u*)(R + off + bj * 128);
                    const f32x4 r0 = (f32x4){bflo(x.x), bfhi(x.x), bflo(x.y), bfhi(x.y)} + acc[ai][bj][m][0], r1 = (f32x4){bflo(x.z), bfhi(x.z), bflo(x.w), bfhi(x.w)} + acc[ai][bj][m][1];
                    sq += (r0[0] * r0[0] + r0[1] * r0[1]) + (r0[2] * r0[2] + r0[3] * r0[3]) + (r1[0] * r1[0] + r1[1] * r1[1]) + (r1[2] * r1[2] + r1[3] * r1[3]);
                    acc[ai][bj][m][0] = r0; acc[ai][bj][m][1] = r1; }
                sq += __shfl_xor(sq, 16); sq += __shfl_xor(sq, 32);
                if (fq == 0) atomicAdd(ss + row0 + ai * 128 + m * 16, sq); }
        asm volatile("s_waitcnt vmcnt(0)" ::: "memory");
        unsigned* pc = cnt + 64 * u.pm;
        if (lane == 0) __hip_atomic_fetch_add(pc, 1u, __ATOMIC_RELAXED, __HIP_MEMORY_SCOPE_AGENT);
        if (wid == 0) { unsigned spins = 0;
            while ((unsigned)__builtin_amdgcn_readfirstlane(__hip_atomic_load(pc, __ATOMIC_RELAXED, __HIP_MEMORY_SCOPE_AGENT)) < 64u && ++spins < (1u << 22)) __builtin_amdgcn_s_sleep(2);
            __builtin_amdgcn_fence(__ATOMIC_ACQUIRE, "agent"); }
        asm volatile("s_waitcnt vmcnt(0) lgkmcnt(0)" ::: "memory"); __builtin_amdgcn_s_barrier(); asm volatile("" ::: "memory");
#pragma unroll
        for (int ai = 0; ai < 2; ++ai)
#pragma unroll
            for (int m = 0; m < 4; ++m) { const int row = row0 + ai * 128 + m * 16; const size_t off = (size_t)row * ldc + col0;
                const float rs = __builtin_amdgcn_rsqf(__hip_atomic_load(ss + row, __ATOMIC_RELAXED, __HIP_MEMORY_SCOPE_AGENT) * (1.0f / D) + EPS);
#pragma unroll
                for (int bj = 0; bj < 2; ++bj) { const f32x4 r0 = acc[ai][bj][m][0], r1 = acc[ai][bj][m][1];
                    const f32x4 w0 = *(const f32x4*)(w + col0 + bj * 128), w1 = *(const f32x4*)(w + col0 + bj * 128 + 4);
                    *(f32x4*)(out + off + bj * 128) = r0 * rs * w0; *(f32x4*)(out + off + bj * 128 + 4) = r1 * rs * w1; } }
    }
};
__device__ __forceinline__ float silu_f(float g) { return g * __builtin_amdgcn_rcpf(1.0f + __builtin_amdgcn_exp2f(-1.4426950408889634f * g)); }
struct EpiSwiglu {
    static constexpr bool PERM = true, AFTER_DRAIN = false;
    bf16* O; int ldc; const float* ss;
    __device__ __forceinline__ void operator()(const pg8::f32x4 (&acc)[2][2][4][2], const pg8::Unit& u, int wr, int wc, int fr, int fq) const {
        const int row0 = u.pm * 256 + wr * 64 + fr, col0 = u.pn * 128 + wc * 32 + 8 * fq;
#pragma unroll
        for (int ai = 0; ai < 2; ++ai)
#pragma unroll
            for (int m = 0; m < 4; ++m) { bf16* rowp = O + (size_t)(row0 + ai * 128 + m * 16) * ldc + col0; const float rs = rstd_of(ss, row0 + ai * 128 + m * 16);
                float o[8];
#pragma unroll
                for (int n = 0; n < 2; ++n)
#pragma unroll
                    for (int j = 0; j < 4; ++j) o[4 * n + j] = silu_f(acc[ai][0][m][n][j] * rs) * (acc[ai][1][m][n][j] * rs);
                v4u w; w.x = cvtpk(o[0], o[1]); w.y = cvtpk(o[2], o[3]); w.z = cvtpk(o[4], o[5]); w.w = cvtpk(o[6], o[7]);
                *(v4u*)rowp = w; }
    }
};
typedef GAS unsigned gu32;
#define RLX_AGENT __ATOMIC_RELAXED, __HIP_MEMORY_SCOPE_AGENT
#define XB_TMO      128
#define XB_XCNT(j)  (256  + 64 * (j))
#define XB_XSUB(j)  (1280 + 64 * (j))
#define XB_XGEN(j)  (2304 + 64 * (j))
#define XB_TOP      3328
#define XB_TOPGEN   3392
#define XCD_BAR_WORDS 3456
#define XB_SPIN_CAP (1u << 18)

__device__ __forceinline__ unsigned xb_ld(unsigned* p)              { return __hip_atomic_load(p, __ATOMIC_RELAXED, __HIP_MEMORY_SCOPE_AGENT); }
__device__ __forceinline__ unsigned xb_add(unsigned* p, unsigned v) { return __hip_atomic_fetch_add(p, v, __ATOMIC_RELAXED, __HIP_MEMORY_SCOPE_AGENT); }
__device__ __forceinline__ unsigned xb_xcc_id() { return (unsigned)__builtin_amdgcn_s_getreg((3 << 11) | 20) & 0xFu; }
#define XB_SPIN(cond, bar) do { unsigned _sp = 0; while (cond) { __builtin_amdgcn_s_sleep(1); \
    if ((++_sp & 255u) == 0u) { if (xb_ld(&(bar)[XB_TMO])) break; if (_sp > XB_SPIN_CAP) { atomicAdd(&(bar)[XB_TMO], 1u); break; } } } } while (0)

struct XcdBarrier {
    unsigned* bar; unsigned x;
    volatile LAS unsigned* st;
};

__device__ __forceinline__ XcdBarrier xcd_barrier_post(unsigned* bar, volatile LAS unsigned* st) {
    XcdBarrier b; b.bar = bar; b.x = xb_xcc_id(); b.st = st;
    if (threadIdx.x == 0) (void)xb_add(&bar[XB_XCNT(b.x)], 1u);
    return b;
}
__device__ __forceinline__ void xcd_barrier_complete(unsigned* bar, unsigned x, unsigned& nloc, unsigned& nx) {
    const unsigned G = gridDim.x * gridDim.y * gridDim.z;
    unsigned sum, cnt, mine, sp = 0u;
    for (;;) {
        sum = 0u; cnt = 0u; mine = 0u;
#pragma unroll
        for (unsigned j = 0; j < 16; ++j) { const unsigned c = xb_ld(&bar[XB_XCNT(j)]); sum += c; cnt += (c > 0u) ? 1u : 0u; mine = (j == x) ? c : mine; }
        if (sum == G) break;
        __builtin_amdgcn_s_sleep(1);
        if ((++sp & 255u) == 0u) { if (xb_ld(&bar[XB_TMO])) break; if (sp > XB_SPIN_CAP) { atomicAdd(&bar[XB_TMO], 1u); break; } }
    }
    nloc = mine > 0u ? mine : 1u; nx = cnt > 0u ? cnt : 1u;
}

__device__ __forceinline__ void xcd_barrier(const XcdBarrier& b) {
    asm volatile("s_waitcnt vmcnt(0)" ::: "memory");
    __syncthreads();
    if (threadIdx.x == 0) {
        unsigned* bar = b.bar;
        __builtin_amdgcn_s_waitcnt(0);
        unsigned nloc = b.st[0], nx = b.st[1];
        if (nloc == 0u) { xcd_barrier_complete(bar, b.x, nloc, nx); b.st[0] = nloc; b.st[1] = nx; }
        const unsigned old = xb_add(&bar[XB_XSUB(b.x)], 1u);
        const unsigned gen = old / nloc;
        if (old + 1u == (gen + 1u) * nloc) {
            __builtin_amdgcn_fence(__ATOMIC_RELEASE, "agent");
            asm volatile("s_waitcnt vmcnt(0)" ::: "memory");
            const unsigned og = xb_add(&bar[XB_TOP], 1u);
            const unsigned tg = og / nx;
            if (og + 1u == (tg + 1u) * nx) xb_add(&bar[XB_TOPGEN], 1u);
            else XB_SPIN(xb_ld(&bar[XB_TOPGEN]) == tg, bar);
            __builtin_amdgcn_fence(__ATOMIC_ACQUIRE, "agent");
            xb_add(&bar[XB_XGEN(b.x)], 1u);
            asm volatile("s_waitcnt vmcnt(0)" ::: "memory");
        } else {
            XB_SPIN(xb_ld(&bar[XB_XGEN(b.x)]) == gen, bar);
            __builtin_amdgcn_fence(__ATOMIC_ACQUIRE, "agent");
            asm volatile("s_waitcnt vmcnt(0)" ::: "memory");
        }
    }
    __syncthreads();
}
struct TrItem { const float* src; const float* gain; bf16* dst; int ldw; int K; float gs; int ncols; };
__device__ __forceinline__ void tr_load(const TrItem& it, f32x4 (&v)[16], int lane) {
    const int q = lane >> 4, n4 = lane & 15;
    if (4 * n4 < it.ncols) {
#pragma unroll
        for (int j = 0; j < 8; ++j)
#pragma unroll
            for (int hf = 0; hf < 2; ++hf) v[2 * j + hf] = *(const f32x4*)(it.src + (size_t)(8 * j + 2 * q + hf) * it.ldw + 4 * n4);
    } else {
#pragma unroll
        for (int i = 0; i < 16; ++i) v[i] = (f32x4){0.f, 0.f, 0.f, 0.f};
    }
}
__device__ __forceinline__ void tr_store(const TrItem& it, f32x4 (&v)[16], LAS unsigned* scr, int lane) {
    const int q = lane >> 4, n4 = lane & 15;
#pragma unroll
    for (int j = 0; j < 8; ++j) {
        float g0 = it.gs, g1 = it.gs;
        if (it.gain) { g0 *= it.gain[8 * j + 2 * q]; g1 *= it.gain[8 * j + 2 * q + 1]; }
#pragma unroll
        for (int c = 0; c < 4; ++c) scr[(4 * n4 + c) * 33 + 4 * j + q] = cvtpk(v[2 * j][c] * g0, v[2 * j + 1][c] * g1);
    }
    const int pc = lane & 7;
#pragma unroll
    for (int r = 0; r < 8; ++r) { const int n = 8 * r + (lane >> 3); const LAS unsigned* sp = scr + n * 33 + 4 * pc;
        v4u o = {sp[0], sp[1], sp[2], sp[3]};
        if (n < it.ncols) *(v4u*)(it.dst + (size_t)n * it.K + 8 * pc) = o; }
}
struct Args { const float* in[15]; float* out; unsigned char* ws; };
#define CAS __attribute__((address_space(4)))
__device__ __forceinline__ const float* argp(int i) { const CAS unsigned char* kp = (const CAS unsigned char*)__builtin_amdgcn_kernarg_segment_ptr(); asm volatile("" : "+s"(kp));
    const unsigned long long v = *(const CAS unsigned long long*)(kp + 8 * i); return (const float*)(const GAS float*)v; }
__device__ __forceinline__ unsigned char* wsp() { return (unsigned char*)argp(16); }
__device__ __forceinline__ int launder(int v) { asm volatile("" : "+v"(v)); return v; }

__device__ __forceinline__ int gu_row(int c0) { return c0 < FF ? 256 * (c0 >> 7) + (c0 & 127) : 256 * ((c0 - FF) >> 7) + 128 + ((c0 - FF) & 127); }

constexpr int I_IN = 96 * 32, I_GL = 32, I_SQ = 32 * 32, I_GU = 176 * 32, I_DN = 32 * 88, I_KV = 64 * 32;
constexpr int NITEMS_A = I_IN + I_GL + I_SQ + I_GU + I_DN + I_SQ + I_KV;
constexpr int NITEMS_B = NITEMS_A + I_SQ + I_GU;
constexpr int NITEMS = I_IN + I_GL + I_SQ + 2 * I_GU + 2 * I_DN + I_SQ + I_KV + I_SQ;
__device__ __forceinline__ TrItem tr_decode(int it) {
    unsigned char* ws = wsp();
    int r = it;
    const float* W; int ldw, K, ng, c0off = 0, ncols = 64, mode = 0, drowoff = 0; const float* gain = nullptr; float gs = 1.f; bf16* WT;
    if (r < I_IN) { W = argp(3); ldw = GIN; K = D; ng = 96; gain = argp(1); WT = (bf16*)(ws + WS_WIN); mode = 2; }
    else if ((r -= I_IN) < I_GL) { W = argp(3); ldw = GIN; K = D; ng = 1; c0off = NQ3; ncols = 16; gain = argp(1); WT = (bf16*)(ws + WS_WGL); }
    else if ((r -= I_GL) < I_SQ) { W = argp(7); ldw = D; K = D; ng = 32; WT = (bf16*)(ws + WS_WOUT); }
    else if ((r -= I_SQ) < I_GU) { W = argp(12); ldw = FF2; K = D; ng = 176; gain = argp(2); WT = (bf16*)(ws + WS_WGU0); mode = 1; }
    else if ((r -= I_GU) < I_DN) { W = argp(13); ldw = D; K = FF; ng = 32; WT = (bf16*)(ws + WS_WD0); }
    else if ((r -= I_DN) < I_SQ) { W = argp(10); ldw = D; K = D; ng = 32; gain = argp(1) + D; gs = C2; WT = (bf16*)(ws + WS_WQKV); }
    else if ((r -= I_SQ) < I_KV) { W = argp(9); ldw = 2 * D; K = D; ng = 64; gain = argp(8); WT = (bf16*)(ws + WS_WQKV); drowoff = D; }
    else if ((r -= I_KV) < I_SQ) { W = argp(11); ldw = D; K = D; ng = 32; WT = (bf16*)(ws + WS_WSBO); }
    else if ((r -= I_SQ) < I_GU) { W = argp(12) + (size_t)D * FF2; ldw = FF2; K = D; ng = 176; gain = argp(2) + D; WT = (bf16*)(ws + WS_WGU1); mode = 1; }
    else { r -= I_GU; W = argp(13) + (size_t)FF * D; ldw = D; K = FF; ng = 32; WT = (bf16*)(ws + WS_WD1); }
    const int kb = r / ng, nb = r - kb * ng, c0 = c0off + 64 * nb, k0 = 64 * kb;
    int drow0 = (mode == 1) ? gu_row(64 * nb) : drowoff + 64 * nb;
    if (ncols == 16) drow0 = 0;
    if (mode == 2 && c0 < GQK) gs = 0.0625f;
    TrItem t; t.src = W + (size_t)k0 * ldw + c0; t.gain = gain ? gain + k0 : nullptr; t.dst = WT + (size_t)drow0 * K + k0; t.ldw = ldw; t.K = K; t.gs = gs; t.ncols = ncols;
    return t;
}
__device__ __forceinline__ void p0_weights(LAS unsigned char* lds, int lo, int hi, int p, int NP, int wave, int lane) {
    LAS unsigned* scr = (LAS unsigned*)(lds + wave * 8448);
    f32x4 va[16], vb[16];
    int it = lo + p;
    if (it >= hi) return;
    TrItem A = tr_decode(it), B = A;
    tr_load(A, va, lane);
    for (;;) {
        const bool hb = (it + NP < hi);
        if (hb) { B = tr_decode(it + NP); tr_load(B, vb, lane); }
        tr_store(A, va, scr, lane);
        if (!hb) break;
        it += NP;
        const bool ha = (it + NP < hi);
        if (ha) { A = tr_decode(it + NP); tr_load(A, va, lane); }
        tr_store(B, vb, scr, lane);
        if (!ha) break;
        it += NP;
    }
}

__device__ __forceinline__ void rms_rows_bf16(const float* X, bf16* A, int gw, int NGW, int lane) {
    for (int m = gw; m < T; m += NGW) {
        const f32x4* xr = (const f32x4*)(X + (size_t)m * D) + lane;
        f32x4 v[8]; float s = 0.f;
#pragma unroll
        for (int j = 0; j < 8; ++j) { v[j] = xr[64 * j]; s += (v[j].x * v[j].x + v[j].y * v[j].y) + (v[j].z * v[j].z + v[j].w * v[j].w); }
        const float rstd = __builtin_amdgcn_rsqf(wave_sum(s) * (1.0f / D) + EPS);
        v2u* o8 = (v2u*)(A + (size_t)m * D) + lane;
#pragma unroll
        for (int j = 0; j < 8; ++j) { v2u o; o.x = cvtpk(v[j].x * rstd, v[j].y * rstd); o.y = cvtpk(v[j].z * rstd, v[j].w * rstd); o8[64 * j] = o; }
    }
}
__device__ __forceinline__ void rms_rows_gl(LAS unsigned char* lds, const float* X, const float* Win, const float* gain, bf16* A, float* GLB, int gw, int NGW, int tid, int lane) {
    __syncthreads();
    for (int idx = tid; idx < 2048 * 4; idx += NTHR) { const int k = idx >> 2, n4 = idx & 3;
        const f32x4 w = *(const f32x4*)(Win + (size_t)k * GIN + NQ3 + 4 * n4) * gain[k];
        *(LAS f32x4*)(lds + ((((k >> 8) * 4 + (k & 3)) * 4 + n4) * 64 + ((k >> 2) & 63)) * 16) = w; }
    __syncthreads();
    f32x4 vn[8];
    { const f32x4* x0 = (const f32x4*)(X + (size_t)(gw < T ? gw : 0) * D) + lane;
#pragma unroll
      for (int j = 0; j < 8; ++j) vn[j] = x0[64 * j]; }
    for (int m = gw; m < T; m += NGW) {
        f32x4 v[8]; float s = 0.f;
#pragma unroll
        for (int j = 0; j < 8; ++j) { v[j] = vn[j]; s += (v[j].x * v[j].x + v[j].y * v[j].y) + (v[j].z * v[j].z + v[j].w * v[j].w); }
        { const int mn = (m + NGW < T) ? m + NGW : m; const f32x4* xn = (const f32x4*)(X + (size_t)mn * D) + lane;
#pragma unroll
          for (int j = 0; j < 8; ++j) vn[j] = xn[64 * j]; }
        const float rstd = __builtin_amdgcn_rsqf(wave_sum(s) * (1.0f / D) + EPS);
        v2u* o8 = (v2u*)(A + (size_t)m * D) + lane;
#pragma unroll
        for (int j = 0; j < 8; ++j) { v2u o; o.x = cvtpk(v[j].x * rstd, v[j].y * rstd); o.y = cvtpk(v[j].z * rstd, v[j].w * rstd); o8[64 * j] = o; }
        f32x4 p[4];
#pragma unroll
        for (int n4 = 0; n4 < 4; ++n4) p[n4] = (f32x4){0.f, 0.f, 0.f, 0.f};
#pragma unroll
        for (int j = 0; j < 8; ++j)
#pragma unroll
            for (int i = 0; i < 4; ++i)
#pragma unroll
                for (int n4 = 0; n4 < 4; ++n4) p[n4] += *(const LAS f32x4*)(lds + (((j * 4 + i) * 4 + n4) * 64 + lane) * 16) * v[j][i];
        float q8[8], q4[4], q2[2], q1;
        { const bool up = (lane & 32) != 0;
#pragma unroll
          for (int t = 0; t < 8; ++t) { const float lo_ = p[t >> 2][t & 3], hi_ = p[2 + (t >> 2)][t & 3]; const float keep = up ? hi_ : lo_, send = up ? lo_ : hi_; q8[t] = keep + __shfl_xor(send, 32); } }
        { const bool up = (lane & 16) != 0;
#pragma unroll
          for (int t = 0; t < 4; ++t) { const float keep = up ? q8[4 + t] : q8[t], send = up ? q8[t] : q8[4 + t]; q4[t] = keep + __shfl_xor(send, 16); } }
        { const bool up = (lane & 8) != 0;
#pragma unroll
          for (int t = 0; t < 2; ++t) { const float keep = up ? q4[2 + t] : q4[t], send = up ? q4[t] : q4[2 + t]; q2[t] = keep + __shfl_xor(send, 8); } }
        { const bool up = (lane & 4) != 0; const float keep = up ? q2[1] : q2[0], send = up ? q2[0] : q2[1]; q1 = keep + __shfl_xor(send, 4); }
        q1 += __shfl_xor(q1, 2); q1 += __shfl_xor(q1, 1);
        if ((lane & 3) == 0) GLB[(size_t)m * 16 + (lane >> 2)] = q1 * rstd;
    }
}
__device__ __forceinline__ void rms_rows_final(const bf16* Xb, const float* ss, const float* w, float* O, int gw, int NGW, int lane) {
    for (int m = gw; m < T; m += NGW) {
        const float rstd = rstd_of(ss, m);
        const v4u* xr = (const v4u*)(Xb + (size_t)m * D) + lane; const f32x4* wr = (const f32x4*)w + 2 * lane; f32x4* o = (f32x4*)(O + (size_t)m * D) + 2 * lane;
#pragma unroll
        for (int j = 0; j < 4; ++j) { const v4u x = xr[64 * j]; const f32x4 w0 = wr[128 * j], w1 = wr[128 * j + 1];
            o[128 * j] = (f32x4){bflo(x.x) * rstd * w0.x, bfhi(x.x) * rstd * w0.y, bflo(x.y) * rstd * w0.z, bfhi(x.y) * rstd * w0.w};
            o[128 * j + 1] = (f32x4){bflo(x.z) * rstd * w1.x, bfhi(x.z) * rstd * w1.y, bflo(x.w) * rstd * w1.z, bfhi(x.w) * rstd * w1.w}; }
    }
}
__device__ __forceinline__ void gla_post(const bf16* OG, const bf16* QKVR, const float* gw_, bf16* A, int gw, int NGW, int lane) {
    const f32x4 g0 = *((const f32x4*)gw_ + 2 * lane), g1 = *((const f32x4*)gw_ + 2 * lane + 1);
    for (int it = gw; it < T * GH; it += NGW) {
        const int t = it >> 2, h = it & 3;
        const v4u ov = *((const v4u*)(OG + (size_t)t * 2048 + h * 512) + lane);
        const f32x4 a0 = {bflo(ov.x), bfhi(ov.x), bflo(ov.y), bfhi(ov.y)}, a1 = {bflo(ov.z), bfhi(ov.z), bflo(ov.w), bfhi(ov.w)};
        const v4u rr = *((const v4u*)(QKVR + (size_t)t * NQ3 + 4096 + h * 512) + lane);
        float s = (a0.x * a0.x + a0.y * a0.y) + (a0.z * a0.z + a0.w * a0.w) + (a1.x * a1.x + a1.y * a1.y) + (a1.z * a1.z + a1.w * a1.w);
        const float rstd = __builtin_amdgcn_rsqf(wave_sum(s) * (1.0f / GDV) + EPS);
        v4u o;
        o.x = cvtpk(a0.x * rstd * g0.x * silu_f(bflo(rr.x)), a0.y * rstd * g0.y * silu_f(bfhi(rr.x)));
        o.y = cvtpk(a0.z * rstd * g0.z * silu_f(bflo(rr.y)), a0.w * rstd * g0.w * silu_f(bfhi(rr.y)));
        o.z = cvtpk(a1.x * rstd * g1.x * silu_f(bflo(rr.z)), a1.y * rstd * g1.y * silu_f(bfhi(rr.z)));
        o.w = cvtpk(a1.z * rstd * g1.z * silu_f(bflo(rr.w)), a1.w * rstd * g1.w * silu_f(bfhi(rr.w)));
        *((v4u*)(A + (size_t)t * 2048 + h * 512) + lane) = o;
    }
}
__device__ __forceinline__ f32x4 mfma16(bf16x8 a, bf16x8 b, f32x4 c) { return __builtin_amdgcn_mfma_f32_16x16x32_bf16(a, b, c, 0, 0, 0); }
__device__ __forceinline__ float logsig_f(float s) { return fminf(s, 0.f) - __logf(1.0f + __expf(-fabsf(s))); }
constexpr int PR_KT = 0, PR_GL = 33792, PR_HT = 37888, PR_BC = 38912, PR_QL = 105472;
constexpr int KT_ST = 528, BC_ST = 260, VL_ST = 1040;

__device__ __forceinline__ void gla_prep_unit(LAS unsigned char* lds, int unit, int tid, int wave, int lane) {
    unsigned char* ws = wsp();
    const int h = unit & 3, c = (unit >> 2) & 63, b = unit >> 8, bh = b * 4 + h;
    const int t0 = b * SEQ + c * 64;
    const bf16* Aact = (const bf16*)(ws + WS_A); const bf16* WGL = (const bf16*)(ws + WS_WGL); const bf16* QKVR = (const bf16*)(ws + WS_QKVR);
    LAS float* GLP = (LAS float*)(lds + PR_KT); LAS float* GL = (LAS float*)(lds + PR_GL); LAS float* BC = (LAS float*)(lds + PR_BC); LAS float* HT = (LAS float*)(lds + PR_HT);
    const int fr = lane & 15, fq = lane >> 4;
    for (int i = tid; i < 1024; i += NTHR) GL[i] = ((const float*)(ws + WS_VT))[(size_t)t0 * 16 + i];
    __syncthreads();
    {
        const int d = tid & 255, half = tid >> 8;
        const float* Wg = argp(4) + h * 256 + d; float wg[16];
#pragma unroll
        for (int r = 0; r < 16; ++r) wg[r] = Wg[r * GQK];
        const float bias = argp(5)[h * 256 + d];
        float run = 0.f;
        for (int i = 0; i < 32; ++i) { const int row = half * 32 + i; float s = bias;
#pragma unroll
            for (int r4 = 0; r4 < 4; ++r4) { const f32x4 g = *(const LAS f32x4*)(GL + row * 16 + 4 * r4); s += g.x * wg[4 * r4] + g.y * wg[4 * r4 + 1] + g.z * wg[4 * r4 + 2] + g.w * wg[4 * r4 + 3]; }
            run += logsig_f(s) * 0.0625f; BC[row * BC_ST + d] = run; }
        if (half == 0) HT[d] = run;
        __syncthreads();
        if (half == 1) { const float add = HT[d]; for (int i = 32; i < 64; ++i) BC[i * BC_ST + d] += add; }
    }
    for (int p = tid; p < 2048; p += NTHR) { const int row = p >> 5, pc = p & 31;
        *(LAS v4u*)(lds + PR_KT + row * KT_ST + pc * 16) = *(const v4u*)(QKVR + (size_t)(t0 + row) * NQ3 + GQK + h * 256 + pc * 8); }
    __syncthreads();
    bf16* QF = (bf16*)(ws + WS_QB) + (size_t)(bh * 64 + c) * 16384; bf16* KF = (bf16*)(ws + WS_KDT) + (size_t)(bh * 64 + c) * 16384;
    bf16* PF = (bf16*)(ws + WS_KB) + (size_t)(bh * 64 + c) * 4096; float* EB = (float*)(ws + WS_EB);
    for (int p = tid; p < 2048; p += NTHR) { const int fr_ = p & 15, fq_ = (p >> 4) & 3, ks = (p >> 6) & 1, d = ((p >> 7) << 4) + fr_; const float bl = BC[63 * BC_ST + d]; float kd[8];
#pragma unroll
        for (int j = 0; j < 8; ++j) { const int row = 32 * ks + 8 * fq_ + j; const float kv = bf2f(*(const LAS unsigned short*)(lds + PR_KT + row * KT_ST + 2 * d)); kd[j] = kv * __expf(bl - BC[row * BC_ST + d]); }
        v4u o; o.x = cvtpk(kd[0], kd[1]); o.y = cvtpk(kd[2], kd[3]); o.z = cvtpk(kd[4], kd[5]); o.w = cvtpk(kd[6], kd[7]);
        *(v4u*)(KF + (size_t)p * 8) = o; }
    if (tid < 256) EB[(size_t)(bh * 64 + c) * 256 + tid] = __expf(BC[63 * BC_ST + tid]);
    __syncthreads();
    for (int p = tid; p < 2048; p += NTHR) { const int row = p >> 5, g8 = p & 31;
        const v4u q8 = *(const v4u*)(QKVR + (size_t)(t0 + row) * NQ3 + h * 256 + g8 * 8);
        const v4u k8 = *(const LAS v4u*)(lds + PR_KT + row * KT_ST + g8 * 16);
        const f32x4 b0 = *(const LAS f32x4*)(BC + row * BC_ST + 8 * g8), b1 = *(const LAS f32x4*)(BC + row * BC_ST + 8 * g8 + 4);
        const float e0 = __expf(b0.x), e1 = __expf(b0.y), e2 = __expf(b0.z), e3 = __expf(b0.w), e4 = __expf(b1.x), e5 = __expf(b1.y), e6 = __expf(b1.z), e7 = __expf(b1.w);
        v4u qo, ko;
        qo.x = cvtpk(bflo(q8.x) * e0, bfhi(q8.x) * e1); qo.y = cvtpk(bflo(q8.y) * e2, bfhi(q8.y) * e3); qo.z = cvtpk(bflo(q8.z) * e4, bfhi(q8.z) * e5); qo.w = cvtpk(bflo(q8.w) * e6, bfhi(q8.w) * e7);
        ko.x = cvtpk(bflo(k8.x) * __expf(-b0.x), bfhi(k8.x) * __expf(-b0.y)); ko.y = cvtpk(bflo(k8.y) * __expf(-b0.z), bfhi(k8.y) * __expf(-b0.w));
        ko.z = cvtpk(bflo(k8.z) * __expf(-b1.x), bfhi(k8.z) * __expf(-b1.y)); ko.w = cvtpk(bflo(k8.w) * __expf(-b1.z), bfhi(k8.w) * __expf(-b1.w));
        *(LAS v4u*)(lds + PR_QL + row * KT_ST + g8 * 16) = qo; *(LAS v4u*)(lds + PR_KT + row * KT_ST + g8 * 16) = ko; }
    __syncthreads();
    for (int p = tid; p < 2048; p += NTHR) { const int fr_ = p & 15, fq_ = (p >> 4) & 3, m = (p >> 6) & 3, w = p >> 8;
        const v2u lo = *(const LAS v2u*)(lds + PR_QL + (16 * m + fr_) * KT_ST + (32 * w + 4 * fq_) * 2), hi = *(const LAS v2u*)(lds + PR_QL + (16 * m + fr_) * KT_ST + (32 * w + 16 + 4 * fq_) * 2);
        v4u o = {lo.x, lo.y, hi.x, hi.y}; *(v4u*)(QF + (size_t)p * 8) = o; }
    {
        const int mi = wave >> 1, j0 = 2 * (wave & 1);
        if (j0 <= mi) {
            f32x4 p0 = {0.f, 0.f, 0.f, 0.f}, p1 = {0.f, 0.f, 0.f, 0.f}; const bool two = (j0 + 1 <= mi);
#pragma unroll
            for (int s8 = 0; s8 < 8; ++s8) { const bf16x8 aq = *(const LAS bf16x8*)(lds + PR_QL + (16 * mi + fr) * KT_ST + (32 * s8 + 8 * fq) * 2);
                const bf16x8 k0 = *(const LAS bf16x8*)(lds + PR_KT + (16 * j0 + fr) * KT_ST + (32 * s8 + 8 * fq) * 2); p0 = mfma16(aq, k0, p0);
                if (two) { const bf16x8 k1 = *(const LAS bf16x8*)(lds + PR_KT + (16 * (j0 + 1) + fr) * KT_ST + (32 * s8 + 8 * fq) * 2); p1 = mfma16(aq, k1, p1); } }
#pragma unroll
            for (int r = 0; r < 4; ++r) { const int ti = 16 * mi + 4 * fq + r;
                const float v0 = (16 * j0 + fr <= ti) ? p0[r] : 0.f, v1 = (two && (16 * (j0 + 1) + fr <= ti)) ? p1[r] : 0.f;
                *(LAS unsigned short*)(lds + PR_BC + ti * 144 + (16 * j0 + fr) * 2) = (unsigned short)(cvtpk(v0, 0.f) & 0xffffu);
                *(LAS unsigned short*)(lds + PR_BC + ti * 144 + (16 * (j0 + 1) + fr) * 2) = (unsigned short)(cvtpk(v1, 0.f) & 0xffffu); }
        } else {
#pragma unroll
            for (int r = 0; r < 4; ++r) { const int ti = 16 * mi + 4 * fq + r;
                *(LAS unsigned short*)(lds + PR_BC + ti * 144 + (16 * j0 + fr) * 2) = 0; *(LAS unsigned short*)(lds + PR_BC + ti * 144 + (16 * (j0 + 1) + fr) * 2) = 0; }
        }
    }
    __syncthreads();
    { const int p = tid, fr_ = p & 15, fq_ = (p >> 4) & 3, ks = (p >> 6) & 1, m = p >> 7;
      *(v4u*)(PF + (size_t)p * 8) = *(const LAS v4u*)(lds + PR_BC + (16 * m + fr_) * 144 + (32 * ks + 8 * fq_) * 2); }
    __syncthreads();
}

__device__ __forceinline__ bf16x8 pack8(f32x4 lo, f32x4 hi) { v4u w; w.x = cvtpk(lo[0], lo[1]); w.y = cvtpk(lo[2], lo[3]); w.z = cvtpk(hi[0], hi[1]); w.w = cvtpk(hi[2], hi[3]); return __builtin_bit_cast(bf16x8, w); }
struct ScanOps { bf16x8 qf[4], kf[4], px; f32x4 e0, e1; };
constexpr int SC_VB = 65536;
__device__ __forceinline__ s16x4 tr_rd(unsigned a) { s16x4 r; asm volatile("ds_read_b64_tr_b16 %0, %1" : "=v"(r) : "v"(a) : "memory"); return r; }
template <bool LOADER> __device__ __forceinline__ void scan_load(ScanOps& o, const bf16* qf_b, const bf16* kf_b, const bf16* px_b, int px_stride, const float* eb_b, int c, int lane) {
    const unsigned lo = (unsigned)lane * 16u;
    const char* q = (const char*)(qf_b + (size_t)c * 16384); const char* k = (const char*)(kf_b + (size_t)c * 16384); const char* p = (const char*)(px_b + (size_t)c * px_stride);
    o.px = LOADER ? *(const bf16x8*)p : *(const bf16x8*)(p + lo);
#pragma unroll
    for (int m = 0; m < 4; ++m) o.qf[m] = *(const bf16x8*)(q + lo + m * 1024);
#pragma unroll
    for (int i = 0; i < 4; ++i) o.kf[i] = *(const bf16x8*)(k + lo + i * 1024);
    const unsigned eo = (unsigned)(lane >> 4) * 16u; const char* e = (const char*)(eb_b + c * 256);
    o.e0 = *(const f32x4*)(e + eo); o.e1 = *(const f32x4*)(e + eo + 64);
}
template <bool LOADER> __device__ __forceinline__ void scan_step(const ScanOps& o, const bf16x8& nxt_px, f32x4& S0, f32x4& S1, LAS unsigned char* lds, int c, bf16* og, int tid, int wave, int lane, int mp, int ksp) {
    LAS float* PART = (LAS float*)(lds + (c & 1) * 32768);
    const unsigned va = (unsigned)(uintptr_t)(lds + SC_VB + (c & 1) * 2048) + (unsigned)(lane >> 4) * 256u + (unsigned)(lane & 15) * 8u;
    const s16x4 t0 = tr_rd(va), t1 = tr_rd(va + 128u), t2 = tr_rd(va + 1024u), t3 = tr_rd(va + 1152u);
    asm volatile("s_waitcnt lgkmcnt(0)" ::: "memory"); __builtin_amdgcn_sched_barrier(0);
    const bf16x8 vb0 = (bf16x8){t0[0], t0[1], t0[2], t0[3], t1[0], t1[1], t1[2], t1[3]}, vb1 = (bf16x8){t2[0], t2[1], t2[2], t2[3], t3[0], t3[1], t3[2], t3[3]};
    f32x4 ao[4];
    { const bf16x8 Sb = pack8(S0, S1);
#pragma unroll
      for (int m = 0; m < 4; ++m) ao[m] = mfma16(o.qf[m], Sb, (f32x4){0.f, 0.f, 0.f, 0.f}); }
    if constexpr (!LOADER) {
        const bf16x8 vs = ksp ? vb1 : vb0;
        const f32x4 oi = mfma16(o.px, vs, (f32x4){0.f, 0.f, 0.f, 0.f});
#pragma unroll
        for (int m = 0; m < 4; ++m) { const bool on = (m == mp);
#pragma unroll
            for (int r = 0; r < 4; ++r) ao[m][r] += on ? oi[r] : 0.f; }
    }
    S0 = S0 * o.e0; S1 = S1 * o.e1;
    S0 = mfma16(o.kf[0], vb0, S0); S0 = mfma16(o.kf[1], vb1, S0); S1 = mfma16(o.kf[2], vb0, S1); S1 = mfma16(o.kf[3], vb1, S1);
#pragma unroll
    for (int m = 0; m < 4; ++m)
#pragma unroll
        for (int r = 0; r < 4; ++r) PART[((wave * 4 + m) * 4 + r) * 64 + lane] = ao[m][r];
    if constexpr (LOADER) *(LAS bf16x8*)(lds + SC_VB + ((c + 1) & 1) * 2048 + (wave - 6) * 1024 + lane * 16) = nxt_px;
    __syncthreads();
    { const int idx = 2 * tid, m_ = idx >> 8, r_ = (idx >> 6) & 3, l_ = idx & 63, tok = 16 * m_ + 4 * (l_ >> 4) + r_; float s0 = 0.f, s1 = 0.f;
#pragma unroll
      for (int w = 0; w < 8; ++w) { const LAS float* pp = PART + w * 1024 + idx; s0 += pp[0]; s1 += pp[1]; }
      *(unsigned*)(og + (size_t)tok * 2048 + (l_ & 15)) = cvtpk(s0, s1); }
}
template <bool LOADER> __device__ __forceinline__ void gla_scan_waves(LAS unsigned char* lds, int unit, int tid, int wave, int lane) {
    unsigned char* ws = wsp();
    const int bh = unit & 7, sl = unit >> 3, b = bh >> 2, h = bh & 3;
    const bf16* qf_b = (const bf16*)(ws + WS_QB) + (size_t)bh * 64 * 16384 + wave * 2048;
    const bf16* kf_b = (const bf16*)(ws + WS_KDT) + (size_t)bh * 64 * 16384 + wave * 2048;
    const int mp = wave < 2 ? wave : 2 + ((wave - 2) >> 1), ksp = wave < 2 ? 0 : ((wave - 2) & 1);
    const bf16* px_b = LOADER ? (const bf16*)(ws + WS_QKVR) + (size_t)(b * SEQ + (wave - 6) * 32 + (lane >> 1)) * NQ3 + 2048 + h * 512 + sl * 16 + (lane & 1) * 8
                              : (const bf16*)(ws + WS_KB) + (size_t)bh * 64 * 4096 + (mp * 2 + ksp) * 512;
    constexpr int PXS = LOADER ? 64 * NQ3 : 4096;
    const float* eb_b = (const float*)(ws + WS_EB) + (size_t)bh * 64 * 256 + 32 * wave;
    bf16* og_b = (bf16*)(ws + WS_OG) + (size_t)(b * SEQ) * 2048 + h * 512 + sl * 16;
    f32x4 S0 = {0.f, 0.f, 0.f, 0.f}, S1 = {0.f, 0.f, 0.f, 0.f};
    ScanOps A, B, C;
    scan_load<LOADER>(A, qf_b, kf_b, px_b, PXS, eb_b, 0, lane);
    scan_load<LOADER>(B, qf_b, kf_b, px_b, PXS, eb_b, 1, lane);
    if constexpr (LOADER) *(LAS bf16x8*)(lds + SC_VB + (wave - 6) * 1024 + lane * 16) = A.px;
    __syncthreads();
    for (int c = 0; c < 63; c += 3) {
        scan_load<LOADER>(C, qf_b, kf_b, px_b, PXS, eb_b, c + 2, lane);
        scan_step<LOADER>(A, B.px, S0, S1, lds, c, og_b + (size_t)c * 64 * 2048, tid, wave, lane, mp, ksp);
        scan_load<LOADER>(A, qf_b, kf_b, px_b, PXS, eb_b, c + 3, lane);
        scan_step<LOADER>(B, C.px, S0, S1, lds, c + 1, og_b + (size_t)(c + 1) * 64 * 2048, tid, wave, lane, mp, ksp);
        scan_load<LOADER>(B, qf_b, kf_b, px_b, PXS, eb_b, c + 4 < 64 ? c + 4 : 63, lane);
        scan_step<LOADER>(C, A.px, S0, S1, lds, c + 2, og_b + (size_t)(c + 2) * 64 * 2048, tid, wave, lane, mp, ksp);
    }
    scan_step<LOADER>(A, A.px, S0, S1, lds, 63, og_b + (size_t)63 * 64 * 2048, tid, wave, lane, mp, ksp);
    __syncthreads();
}
__device__ __forceinline__ void gla_scan_unit(LAS unsigned char* lds, int unit, int tid, int wave, int lane) {
    if (wave >= 6) gla_scan_waves<true>(lds, unit, tid, wave, lane); else gla_scan_waves<false>(lds, unit, tid, wave, lane);
}
#define KSWZ(row, colB) ((row) * 256 + ((colB) ^ (((row) & 7) << 4)))
#define SBAR() __builtin_amdgcn_sched_barrier(0)
__device__ __forceinline__ int crow(int r, int hi) { return (r & 3) + 8 * (r >> 2) + 4 * hi; }
constexpr int AT_V = 0, AT_K = 16384, AT_FL = 32768, AT_ST = 36864;
__device__ __forceinline__ void qkt(f32x16& p0, f32x16& p1, const LAS unsigned char* Ks, const bf16x8* qr, int r32, int hi) {
    p0 = (f32x16){}; p1 = (f32x16){};
    __builtin_amdgcn_s_setprio(1);
#pragma unroll
    for (int d0 = 0; d0 < 8; ++d0) { const int cb = (d0 * 16 + hi * 8) * 2;
        const bf16x8 b0 = *(const LAS bf16x8*)(Ks + KSWZ(r32, cb));
        const bf16x8 b1 = *(const LAS bf16x8*)(Ks + KSWZ(32 + r32, cb));
        p0 = __builtin_amdgcn_mfma_f32_32x32x16_bf16(b0, qr[d0], p0, 0, 0, 0);
        p1 = __builtin_amdgcn_mfma_f32_32x32x16_bf16(b1, qr[d0], p1, 0, 0, 0); }
    __builtin_amdgcn_s_setprio(0);
}
__device__ __forceinline__ int v_st(int k, int c) { const int kk = (k & ~0xC) | ((k & 4) << 1) | ((k & 8) >> 1); return ((kk >> 3) * 4 + (c >> 5)) * 512 + ((kk & 7) * 32 + (c & 31)) * 2; }
__device__ __forceinline__ int v_rd_base(int lane) { return ((lane & 3) << 3) | (((lane >> 2) & 3) << 6) | (((lane >> 4) & 1) << 5) | (((lane >> 5) & 1) << 8); }
constexpr int v_rd_off(int d0, int ks, int half) { return d0 * 512 + ks * 4096 + half * 2048; }
template <int OFF> __device__ __forceinline__ s16x4 tr_read(int vb) {
    s16x4 r; asm volatile("ds_read_b64_tr_b16 %0, %1 offset:%2" : "=&v"(r) : "v"(vb), "i"(OFF) : "memory"); return r;
}
template <int D0> __device__ __forceinline__ void pv_one(f32x16& od, int vb, bf16x8 pa0, bf16x8 pa1, bf16x8 pa2, bf16x8 pa3) {
    const s16x4 l0 = tr_read<v_rd_off(D0, 0, 0)>(vb), h0 = tr_read<v_rd_off(D0, 0, 1)>(vb), l1 = tr_read<v_rd_off(D0, 1, 0)>(vb), h1 = tr_read<v_rd_off(D0, 1, 1)>(vb);
    const s16x4 l2 = tr_read<v_rd_off(D0, 2, 0)>(vb), h2 = tr_read<v_rd_off(D0, 2, 1)>(vb), l3 = tr_read<v_rd_off(D0, 3, 0)>(vb), h3 = tr_read<v_rd_off(D0, 3, 1)>(vb);
    asm volatile("s_waitcnt lgkmcnt(0)" ::: "memory"); SBAR();
#define PK(L, H) (bf16x8){L[0], L[1], L[2], L[3], H[0], H[1], H[2], H[3]}
    __builtin_amdgcn_s_setprio(1);
    od = __builtin_amdgcn_mfma_f32_32x32x16_bf16(pa0, PK(l0, h0), od, 0, 0, 0);
    od = __builtin_amdgcn_mfma_f32_32x32x16_bf16(pa1, PK(l1, h1), od, 0, 0, 0);
    od = __builtin_amdgcn_mfma_f32_32x32x16_bf16(pa2, PK(l2, h2), od, 0, 0, 0);
    od = __builtin_amdgcn_mfma_f32_32x32x16_bf16(pa3, PK(l3, h3), od, 0, 0, 0);
    __builtin_amdgcn_s_setprio(0);
#undef PK
}
template <bool MASKED> __device__ __forceinline__ void sb_transform(f32x16& p, int kbase, int tq, int hi, float& carry) {
    float f[16];
#pragma unroll
    for (int r = 0; r < 16; ++r) { const float u = __builtin_amdgcn_exp2f(fminf(p[r], 100.f)); const float rr = __builtin_amdgcn_rcpf(1.0f + u);
        const bool valid = !MASKED || (kbase + crow(r, hi) < tq);
        f[r] = valid ? rr : 1.0f; p[r] = valid ? u * rr : 0.f; }
    float run = carry;
#pragma unroll
    for (int g = 3; g >= 0; --g) {
        const float G = (f[4 * g] * f[4 * g + 1]) * (f[4 * g + 2] * f[4 * g + 3]);
        const float O = __shfl_xor(G, 32);
        const float a3 = hi == 0 ? run * O : run, a2 = a3 * f[4 * g + 3], a1 = a2 * f[4 * g + 2], a0 = a1 * f[4 * g + 1];
        p[4 * g + 3] *= a3; p[4 * g + 2] *= a2; p[4 * g + 1] *= a1; p[4 * g] *= a0;
        run *= G * O;
    }
    carry = run;
}
__device__ __forceinline__ void sb_pack(const f32x16& p0, const f32x16& p1, bf16x8& pa0, bf16x8& pa1, bf16x8& pa2, bf16x8& pa3) {
#define PK4(P, BASE, OUT) do { unsigned a0 = cvtpk(P[BASE + 0], P[BASE + 1]), a1 = cvtpk(P[BASE + 2], P[BASE + 3]);   \
    unsigned b0 = cvtpk(P[BASE + 4], P[BASE + 5]), b1 = cvtpk(P[BASE + 6], P[BASE + 7]);                              \
    auto r0 = __builtin_amdgcn_permlane32_swap(a0, b0, false, false); auto r1 = __builtin_amdgcn_permlane32_swap(a1, b1, false, false); \
    v4u w = {r0[0], r1[0], r0[1], r1[1]}; OUT = __builtin_bit_cast(bf16x8, w); } while (0)
    PK4(p0, 0, pa0); PK4(p0, 8, pa1); PK4(p1, 0, pa2); PK4(p1, 8, pa3);
#undef PK4
}
__device__ __forceinline__ void sb_attn_unit(LAS unsigned char* lds, int unit, int tid, int wid, int lane) {
    unsigned char* ws = wsp();
    const int qblk = unit & 15, bh = unit >> 4, b = bh >> 4, h = bh & 15, r32 = lane & 31, hi = lane >> 5;
    const int q0 = qblk * 256;
    const bf16* QKV = (const bf16*)(ws + WS_QKVR);
    const bf16* Qb = QKV + (size_t)(b * SEQ + q0) * NQ3 + h * HD; const bf16* Kh = QKV + (size_t)(b * SEQ) * NQ3 + 2048 + h * HD; const bf16* Vh = Kh + 2048;
    bf16x8 qr[8];
    { const bf16* Qw = Qb + (size_t)(wid * 32 + r32) * NQ3 + hi * 8;
#pragma unroll
      for (int d0 = 0; d0 < 8; ++d0) qr[d0] = *(const bf16x8*)(Qw + d0 * 16); }
    f32x16 o[4];
#pragma unroll
    for (int d = 0; d < 4; ++d) o[d] = (f32x16){};
    float carry = 1.0f;
    const int twmin = q0 + wid * 32, tq = twmin + r32;
    const int sr = tid >> 4, sc = (tid & 15) * 8, vst0 = v_st(sr, sc), vst1 = v_st(32 + sr, sc);
    const int vb0 = (int)(uintptr_t)(lds + AT_V) + v_rd_base(lane);
    volatile LAS int* FL = (volatile LAS int*)(lds + AT_FL);
    const int nt = (q0 + 256) / 64;
    v4u vs0, vs1, ks0, ks1;
#define SLOAD(k0) do { vs0 = *(const v4u*)(Vh + (size_t)((k0) + sr) * NQ3 + sc); vs1 = *(const v4u*)(Vh + (size_t)((k0) + 32 + sr) * NQ3 + sc); \
    ks0 = *(const v4u*)(Kh + (size_t)((k0) + sr) * NQ3 + sc); ks1 = *(const v4u*)(Kh + (size_t)((k0) + 32 + sr) * NQ3 + sc); } while (0)
    SLOAD((nt - 1) * 64);
    for (int kt = nt - 1; kt >= 0; --kt) {
        __syncthreads();
        if (kt < nt - 1) { int alld = 1;
#pragma unroll
            for (int w = 0; w < 8; ++w) alld &= FL[((kt + 1) & 1) * 8 + w];
            if (alld) break; }
        *(LAS v4u*)(lds + AT_V + vst0) = vs0; *(LAS v4u*)(lds + AT_V + vst1) = vs1;
        *(LAS v4u*)(lds + AT_K + KSWZ(sr, sc * 2)) = ks0; *(LAS v4u*)(lds + AT_K + KSWZ(32 + sr, sc * 2)) = ks1;
        __syncthreads();
        if (kt > 0) SLOAD((kt - 1) * 64);
        const int k0 = kt * 64;
        if (k0 < twmin + 31) {
            f32x16 p0, p1; qkt(p0, p1, lds + AT_K, qr, r32, hi);
            if (k0 + 63 >= twmin) { sb_transform<true>(p1, k0 + 32, tq, hi, carry); sb_transform<true>(p0, k0, tq, hi, carry); }
            else { sb_transform<false>(p1, k0 + 32, tq, hi, carry); sb_transform<false>(p0, k0, tq, hi, carry); }
            bf16x8 pa0, pa1, pa2, pa3; sb_pack(p0, p1, pa0, pa1, pa2, pa3);
            pv_one<0>(o[0], vb0, pa0, pa1, pa2, pa3); pv_one<1>(o[1], vb0, pa0, pa1, pa2, pa3); pv_one<2>(o[2], vb0, pa0, pa1, pa2, pa3); pv_one<3>(o[3], vb0, pa0, pa1, pa2, pa3);
        }
        const int done = __all(carry == 0.0f) ? 1 : 0;
        if (lane == 0) FL[(kt & 1) * 8 + wid] = done;
    }
#undef SLOAD
    bf16* Ow = (bf16*)(ws + WS_OG) + (size_t)(b * SEQ + q0 + wid * 32) * D + h * HD;
    LAS unsigned char* st = lds + AT_ST + wid * 8704;
#pragma unroll
    for (int r = 0; r < 16; ++r) { const int orow = crow(r, hi);
#pragma unroll
        for (int d0 = 0; d0 < 4; ++d0) *(LAS unsigned short*)(st + orow * 272 + (d0 * 32 + r32) * 2) = (unsigned short)(cvtpk(o[d0][r], 0.f) & 0xffffu); }
    LDS_WAIT();
#pragma unroll
    for (int i = 0; i < 8; ++i) { const int p = lane + 64 * i, row = p >> 4, pc = p & 15;
        *(v4u*)(Ow + (size_t)row * D + pc * 8) = *(const LAS v4u*)(st + row * 272 + pc * 16); }
    __syncthreads();
}
#ifndef WGM_GU
#define WGM_GU 4
#endif
#ifndef WGM_DN
#define WGM_DN 4
#endif
#ifndef WGM_QKV
#define WGM_QKV 4
#endif
#ifndef WGM_SQ
#define WGM_SQ 4
#endif
#ifndef PROBE_G7
#define PROBE_G7 1
#endif
#ifndef PROBE_G1
#define PROBE_G1 1
#endif
#ifndef PROBE_P0
#define PROBE_P0 1
#endif
#ifndef PROBE_SCAN
#define PROBE_SCAN 1
#endif
#ifndef PROBE_PREP
#define PROBE_PREP 1
#endif
#ifndef PROBE_ATTN
#define PROBE_ATTN 1
#endif
#define GEMM_PHASE_(EpiT, AOFF, BOFF, N_, K_, Einit, ALIGN) do { unsigned char* ws_ = wsp(); pg8::Gemm g{(const pg8::bf16_t*)(ws_ + (AOFF)), (const pg8::bf16_t*)(ws_ + (BOFF)), T, (N_), (K_)}; \
    pg8::StaticOrder S; S.init(T, (N_), (int)gridDim.x, (int)blockIdx.x, ((N_) == FF2) ? WGM_GU : (((K_) == FF) ? WGM_DN : (((N_) == NQ3) ? WGM_QKV : WGM_SQ))); EpiT E Einit; pg8::gemm_phase<EpiT, pg8::StaticOrder, ALIGN, true>(lds, g, S, E); } while (0)
#define GEMM_PHASE(EpiT, AOFF, BOFF, N_, K_, Einit) GEMM_PHASE_(EpiT, AOFF, BOFF, N_, K_, Einit, true)
#define GEMM_PHASE1(EpiT, AOFF, BOFF, N_, K_, Einit) GEMM_PHASE_(EpiT, AOFF, BOFF, N_, K_, Einit, false)
#define PH_IDS() const int tid = launder((int)threadIdx.x), lane = tid & 63, wave = __builtin_amdgcn_readfirstlane(tid >> 6), G = (int)gridDim.x, bid = (int)blockIdx.x, gw = bid * NWAVES + wave, NGW = G * NWAVES; (void)gw; (void)NGW; (void)lane

__global__ void __launch_bounds__(NTHR, 2) yoco_fwd(Args args) {
    extern __shared__ __attribute__((aligned(16))) unsigned char lds_raw[];
    LAS unsigned char* lds = (LAS unsigned char*)lds_raw;
    cg::grid_group grid = cg::this_grid();
    if (threadIdx.x < 16) ((LAS unsigned*)(lds + MISC_OFF))[threadIdx.x] = 0u;
    __syncthreads();
#define GRID_BAR() do { XcdBarrier b_; b_.bar = (unsigned*)(wsp() + WS_CTL) + 4096; b_.x = xb_xcc_id(); b_.st = (volatile LAS unsigned*)(lds + MISC_OFF) + 8; xcd_barrier(b_); } while (0)
    (void)xcd_barrier_post((unsigned*)(wsp() + WS_CTL) + 4096, (volatile LAS unsigned*)(lds + MISC_OFF) + 8);
    { PH_IDS(); for (int rep = 0; rep < PROBE_P0; ++rep) p0_weights(lds, 0, NITEMS_A, gw, NGW, wave, lane); rms_rows_gl(lds, argp(0), argp(3), argp(1), (bf16*)(wsp() + WS_A), (float*)(wsp() + WS_VT), gw, NGW, tid, lane); }
    if (__builtin_expect(wsp() == nullptr, 0)) grid.sync();
    GRID_BAR();
    for (int rep = 0; rep < PROBE_G1; ++rep) GEMM_PHASE(EpiStoreBf16, WS_A, WS_WIN, NQ3, D, ({(bf16*)(ws_ + WS_QKVR), NQ3, nullptr}));
    GRID_BAR();
    { PH_IDS();
      if (G == 256) { for (int r = 0; r < 2; ++r) { const int j = (r * 256 + bid) >> 3, grp = (bid & 7) * 16 + (j >> 2); gla_prep_unit(lds, (grp << 2) | (j & 3), tid, wave, lane); } }
      else for (int u = bid; u < NBATCH * 64 * GH; u += G) gla_prep_unit(lds, u, tid, wave, lane); }
    GRID_BAR();
    { PH_IDS(); for (int rep = 0; rep < PROBE_SCAN; ++rep) for (int u = bid; u < 256; u += G) gla_scan_unit(lds, u, tid, wave, lane); }
    GRID_BAR();
    { PH_IDS(); unsigned char* ws = wsp(); gla_post((const bf16*)(ws + WS_OG), (const bf16*)(ws + WS_QKVR), argp(6), (bf16*)(ws + WS_A), gw, NGW, lane); }
    GRID_BAR();
    GEMM_PHASE(EpiRes<false>, WS_A, WS_WOUT, D, D, ({argp(0), D, (bf16*)(ws_ + WS_A2), (float*)(ws_ + WS_SS)}));
    GRID_BAR();
    for (int rep = 0; rep < PROBE_G7; ++rep) GEMM_PHASE(EpiSwiglu, WS_A2, WS_WGU0, FF2, D, ({(bf16*)(ws_ + WS_ACT), FF, (const float*)(ws_ + WS_SS)}));
    { PH_IDS();
      if (G == 256) { if (bid >= 128) p0_weights(lds, NITEMS_A, NITEMS_B, (bid - 128) * NWAVES + wave, 128 * NWAVES, wave, lane); }
      else p0_weights(lds, NITEMS_A, NITEMS_B, gw, NGW, wave, lane); }
    GRID_BAR();
    GEMM_PHASE(EpiRes<true>, WS_ACT, WS_WD0, D, FF, ({ws_ + WS_A2, D, (bf16*)(ws_ + WS_A), (float*)(ws_ + WS_SS) + T}));
    GRID_BAR();
    GEMM_PHASE(EpiStoreBf16, WS_A, WS_WQKV, NQ3, D, ({(bf16*)(ws_ + WS_QKVR), NQ3, (const float*)(ws_ + WS_SS) + T}));
    GRID_BAR();
    { PH_IDS(); for (int rep = 0; rep < PROBE_ATTN; ++rep) for (int u = bid; u < NBATCH * SBH * 16; u += G) sb_attn_unit(lds, u, tid, wave, lane); }
    GRID_BAR();
    GEMM_PHASE(EpiRes<true>, WS_OG, WS_WSBO, D, D, ({ws_ + WS_A, D, (bf16*)(ws_ + WS_A2), (float*)(ws_ + WS_SS) + 2 * T}));
    GRID_BAR();
    GEMM_PHASE(EpiSwiglu, WS_A2, WS_WGU1, FF2, D, ({(bf16*)(ws_ + WS_ACT), FF, (const float*)(ws_ + WS_SS) + 2 * T}));
    { PH_IDS();
      if (G == 256) { if (bid >= 128) p0_weights(lds, NITEMS_B, NITEMS, (bid - 128) * NWAVES + wave, 128 * NWAVES, wave, lane); }
      else p0_weights(lds, NITEMS_B, NITEMS, gw, NGW, wave, lane); }
    GRID_BAR();
    if (gridDim.x == 256) {
        GEMM_PHASE(EpiFinal, WS_ACT, WS_WD1, D, FF, ({(const bf16*)(ws_ + WS_A2), D, (float*)(ws_ + WS_SS) + 3 * T, (unsigned*)(ws_ + WS_CTL) + 12288, argp(14), (float*)argp(15)}));
    } else {
        GEMM_PHASE(EpiRes<true>, WS_ACT, WS_WD1, D, FF, ({ws_ + WS_A2, D, (bf16*)(ws_ + WS_A2), (float*)(ws_ + WS_SS) + 3 * T}));
        GRID_BAR();
        { PH_IDS(); unsigned char* ws = wsp(); rms_rows_final((const bf16*)(ws + WS_A2), (const float*)(ws + WS_SS) + 3 * T, argp(14), (float*)argp(15), gw, NGW, lane); }
    }
}

extern "C" void kernel_launch(void* const* d_in, const int* in_sizes, int n_in, void* d_out, int out_size, void* d_ws, size_t ws_size, hipStream_t stream) {
    static int grid = 0;
    if (grid == 0) {
        if (n_in != 15 || in_sizes[0] != T * D || out_size != T * D || ws_size < WS_END) { fprintf(stderr, "kernel_launch: unexpected shapes n_in %d in0 %d out %d ws %zu\n", n_in, n_in > 0 ? in_sizes[0] : -1, out_size, ws_size); grid = -1; return; }
        int dev = 0, cus = 0, per_cu = 0;
        (void)hipGetDevice(&dev); (void)hipDeviceGetAttribute(&cus, hipDeviceAttributeMultiprocessorCount, dev);
        if (hipFuncSetAttribute((const void*)yoco_fwd, hipFuncAttributeMaxDynamicSharedMemorySize, LDS_BYTES) != hipSuccess) { fprintf(stderr, "kernel_launch: hipFuncSetAttribute failed\n"); grid = -1; return; }
        if (hipOccupancyMaxActiveBlocksPerMultiprocessor(&per_cu, (const void*)yoco_fwd, NTHR, LDS_BYTES) != hipSuccess || per_cu < 1) { fprintf(stderr, "kernel_launch: occupancy query says %d\n", per_cu); per_cu = 1; }
        (void)hipGetLastError();
        grid = cus;
    }
    if (grid < 0) return;
    if (hipMemsetAsync((char*)d_ws + WS_CTL, 0, 65536 + 4 * T * 4, stream) != hipSuccess) { fprintf(stderr, "kernel_launch: memset failed\n"); return; }
    Args a{};
    for (int i = 0; i < 15; ++i) a.in[i] = (const float*)d_in[i];
    a.out = (float*)d_out; a.ws = (unsigned char*)d_ws;
    void* kargs[] = {&a};
    hipError_t e = hipLaunchCooperativeKernel((const void*)yoco_fwd, dim3(grid), dim3(NTHR), kargs, LDS_BYTES, stream);
    if (e != hipSuccess) fprintf(stderr, "kernel_launch: cooperative launch failed: %s (grid %d)\n", hipGetErrorString(e), grid);
}
```
